# Optimizing an MI355X kernel written in HIP

```python
import jax, jax.numpy as jnp
from jax import lax
import numpy as np

D_MODEL = 1024
BATCH = 8
SEQ = 4096
DEPTH = 2

GRID_W = 64
HEAD_DIM = 64
FNET_GROUPS = 4
FNET_WIDTH = FNET_GROUPS * HEAD_DIM
SGU_HEADS = 4
SGU_WIDTH = SGU_HEADS * HEAD_DIM
SGU_CHUNK = 128
N_Q_HEADS = 8
N_KV_HEADS = 2
Q_PER_KV = N_Q_HEADS // N_KV_HEADS
Q_WIDTH = N_Q_HEADS * HEAD_DIM
KV_WIDTH = N_KV_HEADS * HEAD_DIM
Q_BLOCK = 128
ROPE_THETA = 10000.0
ROPE_FREQS = HEAD_DIM // 4
D_MIX = FNET_WIDTH + SGU_WIDTH + Q_WIDTH
D_IN = FNET_WIDTH + 2 * SGU_WIDTH + Q_WIDTH + 2 * KV_WIDTH
D_FF = -(-8 * D_MODEL // (3 * 256)) * 256
EPS = 1e-6

kernel_name = "hybrid_fnet_sgu_gqa_encoder"


def rmsnorm(x, g):
    xf = x.astype(jnp.float32)
    y = xf * lax.rsqrt(jnp.mean(xf * xf, axis=-1, keepdims=True) + EPS)
    return (y * g.astype(jnp.float32)).astype(x.dtype)


def layernorm(x, g):
    xf = x.astype(jnp.float32)
    mu = jnp.mean(xf, axis=-1, keepdims=True)
    var = jnp.mean(jnp.square(xf - mu), axis=-1, keepdims=True)
    y = (xf - mu) * lax.rsqrt(var + EPS)
    return (y * g.astype(jnp.float32)).astype(x.dtype)


def fourier_mix(h):
    b, s, _ = h.shape
    hg = h.reshape(b, s, FNET_GROUPS, HEAD_DIM).astype(jnp.float32)
    y = jnp.fft.fft2(hg, axes=(1, 3), norm="ortho").real
    return y.reshape(b, s, FNET_WIDTH).astype(h.dtype)


def spatial_gating(z, w_s, b_s, g_v):
    b, s, _ = z.shape
    z = jax.nn.gelu(z)
    u, v = z[..., :SGU_WIDTH], z[..., SGU_WIDTH:]
    v = layernorm(v, g_v)
    v = v.reshape(b, s // SGU_CHUNK, SGU_CHUNK, SGU_HEADS, HEAD_DIM)
    sv = jnp.einsum('hpq,bnqhc->bnphc', w_s.astype(v.dtype), v) + b_s.T[:, :, None].astype(v.dtype)
    return u * sv.reshape(b, s, SGU_WIDTH)


def axial_rope_tables(s, dtype):
    rows = s // GRID_W
    row = jnp.repeat(jnp.arange(rows), GRID_W).astype(jnp.float32)
    col = jnp.tile(jnp.arange(GRID_W), rows).astype(jnp.float32)
    freqs = ROPE_THETA ** (-jnp.arange(ROPE_FREQS, dtype=jnp.float32) / ROPE_FREQS)
    ang_r = row[:, None] * freqs
    ang_c = col[:, None] * freqs
    return (jnp.cos(ang_r).astype(dtype), jnp.sin(ang_r).astype(dtype),
            jnp.cos(ang_c).astype(dtype), jnp.sin(ang_c).astype(dtype))


def rope_half(x, cos, sin):
    x1, x2 = x[..., :ROPE_FREQS], x[..., ROPE_FREQS:]
    c, sn = cos[:, None, :], sin[:, None, :]
    return jnp.concatenate([x1 * c - x2 * sn, x2 * c + x1 * sn], axis=-1)


def apply_axial_rope(x, tabs):
    cos_r, sin_r, cos_c, sin_c = tabs
    half = HEAD_DIM // 2
    return jnp.concatenate([rope_half(x[..., :half], cos_r, sin_r),
                            rope_half(x[..., half:], cos_c, sin_c)], axis=-1)


def gqa_attention(q, k, v, g_q, g_k, tabs):
    b, s, _ = q.shape
    q = rmsnorm(q.reshape(b, s, N_Q_HEADS, HEAD_DIM), g_q)
    k = rmsnorm(k.reshape(b, s, N_KV_HEADS, HEAD_DIM), g_k)
    v = v.reshape(b, s, N_KV_HEADS, HEAD_DIM)
    q = apply_axial_rope(q, tabs)
    k = apply_axial_rope(k, tabs)
    qb = q.reshape(b, s // Q_BLOCK, Q_BLOCK, N_KV_HEADS, Q_PER_KV, HEAD_DIM).transpose(1, 0, 2, 3, 4, 5)
    scale = HEAD_DIM ** -0.5

    def block(qblk):
        sc = jnp.einsum('bqkgd,bskd->bkgqs', qblk, k).astype(jnp.float32) * scale
        p = jax.nn.softmax(sc, axis=-1).astype(v.dtype)
        return jnp.einsum('bkgqs,bskd->bqkgd', p, v)

    o = lax.map(block, qb)
    return o.transpose(1, 0, 2, 3, 4, 5).reshape(b, s, Q_WIDTH)


def hybrid_mixer(h, w_in, sgu_w, sgu_b, sgu_g, g_q, g_k, g_mix, w_out, tabs):
    z = h @ w_in
    o0 = FNET_WIDTH
    o1 = o0 + 2 * SGU_WIDTH
    o2 = o1 + Q_WIDTH
    o3 = o2 + KV_WIDTH
    y_f = fourier_mix(z[..., :o0])
    y_s = spatial_gating(z[..., o0:o1], sgu_w, sgu_b, sgu_g)
    y_a = gqa_attention(z[..., o1:o2], z[..., o2:o3], z[..., o3:], g_q, g_k, tabs)
    a0 = FNET_WIDTH
    a1 = a0 + SGU_WIDTH
    y = jnp.concatenate([rmsnorm(y_f, g_mix[:a0]),
                         rmsnorm(y_s, g_mix[a0:a1]),
                         rmsnorm(y_a, g_mix[a1:])], axis=-1)
    return y @ w_out


def swiglu(h, w_gate, w_up, w_down):
    return (jax.nn.silu(h @ w_gate) * (h @ w_up)) @ w_down


def setup_inputs(seed: int = 0) -> dict:
    key = jax.random.key(seed)
    ks = jax.random.split(key, 17)
    f32 = jnp.float32

    def gain(k, shape):
        return (1.0 + 0.02 * jax.random.normal(k, shape, f32)).astype(f32)

    def dense(k, shape, fan_in):
        return (jax.random.normal(k, shape, f32) * fan_in ** -0.5).astype(f32)

    return {
        "x": jax.random.normal(ks[0], (BATCH, SEQ, D_MODEL), f32),
        "g_pre_mix": gain(ks[1], (DEPTH, D_MODEL)),
        "w_in": dense(ks[2], (DEPTH, D_MODEL, D_IN), D_MODEL),
        "sgu_w": dense(ks[3], (DEPTH, SGU_HEADS, SGU_CHUNK, SGU_CHUNK), SGU_CHUNK),
        "sgu_b": gain(ks[4], (DEPTH, SGU_HEADS, SGU_CHUNK)),
        "sgu_g": gain(ks[5], (DEPTH, SGU_WIDTH)),
        "g_q": gain(ks[6], (DEPTH, HEAD_DIM)),
        "g_k": gain(ks[7], (DEPTH, HEAD_DIM)),
        "g_mix": gain(ks[8], (DEPTH, D_MIX)),
        "w_out": dense(ks[9], (DEPTH, D_MIX, D_MODEL), D_MIX),
        "g_post_mix": gain(ks[10], (DEPTH, D_MODEL)),
        "g_pre_ffn": gain(ks[11], (DEPTH, D_MODEL)),
        "w_gate": dense(ks[12], (DEPTH, D_MODEL, D_FF), D_MODEL),
        "w_up": dense(ks[13], (DEPTH, D_MODEL, D_FF), D_MODEL),
        "w_down": dense(ks[14], (DEPTH, D_FF, D_MODEL), D_FF),
        "g_post_ffn": gain(ks[15], (DEPTH, D_MODEL)),
    }


def reference(x, g_pre_mix, w_in, sgu_w, sgu_b, sgu_g, g_q, g_k, g_mix, w_out,
              g_post_mix, g_pre_ffn, w_gate, w_up, w_down, g_post_ffn):
    tabs = axial_rope_tables(x.shape[1], x.dtype)
    for l in range(DEPTH):
        h = rmsnorm(x, g_pre_mix[l])
        m = hybrid_mixer(h, w_in[l], sgu_w[l], sgu_b[l], sgu_g[l], g_q[l], g_k[l],
                         g_mix[l], w_out[l], tabs)
        x = x + rmsnorm(m, g_post_mix[l])
        h = rmsnorm(x, g_pre_ffn[l])
        f = swiglu(h, w_gate[l], w_up[l], w_down[l])
        x = x + rmsnorm(f, g_post_ffn[l])
    return x
```

```cpp
#include <hip/hip_runtime.h>
#include <hip/hip_cooperative_groups.h>
#include <hip/hip_bf16.h>
#include <cstdio>
#include <cstdint>
#include <cmath>
namespace cg = cooperative_groups;

#define LAS __attribute__((address_space(3)))
#define GAS __attribute__((address_space(1)))
typedef unsigned short bf16_t;
typedef short bf16x8 __attribute__((ext_vector_type(8)));
typedef float f32x4 __attribute__((ext_vector_type(4)));
typedef float f32x2 __attribute__((ext_vector_type(2)));
typedef unsigned u32x4 __attribute__((ext_vector_type(4)));
typedef unsigned u32x2 __attribute__((ext_vector_type(2)));

constexpr int NB = 8, SEQ = 4096, DM = 1024, MTOK = NB * SEQ, DIN = 1536, DFF = 2816, DEPTH = 2;
constexpr int ZP = 1280;
constexpr int ZC_U = 0, ZC_V = 256, ZC_Q = 512, ZC_K = 1024, ZC_VA = 1152;
constexpr int OP = 512;
constexpr float EPS = 1e-6f;
constexpr int NWAVES = 8, NTHR = 512;

constexpr size_t MiB = 1u << 20;
constexpr size_t WS_CTL = 0;
constexpr size_t WS_W = 1 * MiB;
constexpr size_t WL_IN = 0, WL_F = (size_t)1280 * 1024 * 2, WL_OUT = WL_F + (size_t)512 * 1024 * 2, WL_GU = WL_OUT + (size_t)1024 * 1024 * 2,
                 WL_DN = WL_GU + (size_t)5632 * 1024 * 2, WL_SIZE = WL_DN + (size_t)1024 * 2816 * 2;
static_assert(WL_SIZE == 22 * MiB, "weights per layer");
constexpr size_t WS_DFT = 48 * MiB;
constexpr size_t WS_XN = 112 * MiB;
constexpr size_t WS_MB = 176 * MiB;
constexpr size_t WS_H = 240 * MiB;
constexpr size_t WS_Z = 240 * MiB, WS_ZF = 320 * MiB, WS_O = 352 * MiB, WS_Y = 384 * MiB, WS_END = 448 * MiB;

__device__ __forceinline__ unsigned f2bf(float f) { unsigned u = __builtin_bit_cast(unsigned, f); return (u + 0x7fffu + ((u >> 16) & 1u)) >> 16; }
__device__ __forceinline__ unsigned pk2(float lo, float hi) { return f2bf(lo) | (f2bf(hi) << 16); }
__device__ __forceinline__ float bflo(unsigned w) { return __builtin_bit_cast(float, w << 16); }
__device__ __forceinline__ float bfhi(unsigned w) { return __builtin_bit_cast(float, w & 0xffff0000u); }
__device__ __forceinline__ float wave_sum(float v) {
#pragma unroll
    for (int o = 1; o < 64; o <<= 1) v += __shfl_xor(v, o);
    return v;
}
__device__ __forceinline__ float gelu_tanh(float x) {
    const float t = 1.5957691216057308f * (x + 0.044715f * x * x * x);
    const float e = __builtin_amdgcn_exp2f(-t * 1.4426950408889634f);
    return x * __builtin_amdgcn_rcpf(1.f + e);
}
__device__ __forceinline__ float silu_f(float x) {
    const float e = __builtin_amdgcn_exp2f(-x * 1.4426950408889634f);
    return x * __builtin_amdgcn_rcpf(1.f + e);
}

namespace pg8 {
constexpr int BM = 256, BK = 64, HALF = 128, HTB = HALF * BK * 2, STAGE_BYTES = 8 * HTB, NXCD = 8, WGM = 8;
__host__ __device__ __forceinline__ int lds_byte(int r, int c) { const int st = (r >> 4) * 2 + (c >> 5), rr = r & 15, cc = c & 31, ob = rr * 64 + cc * 2; return st * 1024 + (ob ^ (((ob >> 9) & 1) << 5)); }
__host__ __device__ __forceinline__ void stage_rc(int b, int& R, int& C) { const int st = b / 1024, sb = b % 1024, swz = sb ^ (((sb >> 9) & 1) << 5); R = (st >> 1) * 16 + swz / 64; C = (st & 1) * 32 + (swz % 64) / 2; }
__host__ __device__ __forceinline__ int perm32(int rho) { const int n = rho >> 4, i = rho & 15; return 8 * (i >> 2) + 4 * n + (i & 3); }

struct Unit { int pm, pn; };
struct Gemm { const bf16_t* A; const bf16_t* Bt; int lda, ldb, K; };

struct StaticOrder {
    int nM, nN, nwg, G, c;
    __device__ void init(int M, int N, int G_, int c_) { nM = M / BM; nN = N / BM; nwg = nM * nN; G = G_; c = c_; }
    __device__ bool next(int i, Unit& u) const {
        const long L = (long)i * G + c; if (L >= nwg) return false;
        int wgid = (int)L; { const int q = nwg / NXCD, r = nwg % NXCD, xcd = wgid % NXCD, off = wgid / NXCD; wgid = (xcd < r ? xcd * (q + 1) : r * (q + 1) + (xcd - r) * q) + off; }
        const int nig = WGM * nN, gid = wgid / nig, fm = gid * WGM, gsz = (nM - fm) < WGM ? (nM - fm) : WGM;
        u.pm = fm + ((wgid % nig) % gsz); u.pn = (wgid % nig) / gsz; return true;
    }
};
struct OneUnit {
    int pm, pn, have;
    __device__ bool next(int i, Unit& u) const { if (i != 0 || !have) return false; u.pm = pm; u.pn = pn; return true; }
};

__device__ __forceinline__ unsigned cvt_pk_bf16(float lo, float hi) { unsigned r; asm volatile("v_cvt_pk_bf16_f32 %0, %1, %2" : "=v"(r) : "v"(lo), "v"(hi)); return r; }

template <int ACT  > struct EpiBf16 {
    static constexpr bool PERM = true;
    bf16_t* O; int ldc;
    __device__ __forceinline__ void operator()(const f32x4 (&acc)[2][2][4][2], const Unit& u, int wr, int wc, int fr, int fq) const {
        const int row0 = u.pm * BM + wr * 64 + fr; const int col0 = u.pn * BM + wc * 32 + 8 * fq;
        const bool act = (ACT == 1) && (u.pn < 2);
#pragma unroll
        for (int ai = 0; ai < 2; ++ai)
#pragma unroll
            for (int m = 0; m < 4; ++m) { bf16_t* rowp = O + (size_t)(row0 + ai * HALF + m * 16) * ldc + col0;
#pragma unroll
                for (int bj = 0; bj < 2; ++bj) { f32x4 v0 = acc[ai][bj][m][0], v1 = acc[ai][bj][m][1];
                    if (act) {
#pragma unroll
                        for (int e = 0; e < 4; ++e) { v0[e] = gelu_tanh(v0[e]); v1[e] = gelu_tanh(v1[e]); } }
                    u32x4 w; w.x = cvt_pk_bf16(v0[0], v0[1]); w.y = cvt_pk_bf16(v0[2], v0[3]); w.z = cvt_pk_bf16(v1[0], v1[1]); w.w = cvt_pk_bf16(v1[2], v1[3]);
                    *(u32x4*)(rowp + bj * HALF) = w; } }
    }
};
struct EpiSwiglu {
    static constexpr bool PERM = true;
    bf16_t* O; int ldc;
    __device__ __forceinline__ void operator()(const f32x4 (&acc)[2][2][4][2], const Unit& u, int wr, int wc, int fr, int fq) const {
        const int row0 = u.pm * BM + wr * 64 + fr; const int col0 = u.pn * HALF + wc * 32 + 8 * fq;
#pragma unroll
        for (int ai = 0; ai < 2; ++ai)
#pragma unroll
            for (int m = 0; m < 4; ++m) { bf16_t* rowp = O + (size_t)(row0 + ai * HALF + m * 16) * ldc + col0;
                f32x4 v0, v1;
#pragma unroll
                for (int e = 0; e < 4; ++e) { v0[e] = silu_f(acc[ai][0][m][0][e]) * acc[ai][1][m][0][e]; v1[e] = silu_f(acc[ai][0][m][1][e]) * acc[ai][1][m][1][e]; }
                u32x4 w; w.x = cvt_pk_bf16(v0[0], v0[1]); w.y = cvt_pk_bf16(v0[2], v0[3]); w.z = cvt_pk_bf16(v1[0], v1[1]); w.w = cvt_pk_bf16(v1[2], v1[3]);
                *(u32x4*)rowp = w; }
    }
};
struct EpiF32 {
    static constexpr bool PERM = false;
    float* O; int ldc; float scale;
    __device__ __forceinline__ void operator()(const f32x4 (&acc)[2][2][4][2], const Unit& u, int wr, int wc, int fr, int fq) const {
        const int row0 = u.pm * BM + wr * 64 + fr; const int col0 = u.pn * BM + wc * 32 + 4 * fq;
#pragma unroll
        for (int ai = 0; ai < 2; ++ai)
#pragma unroll
            for (int m = 0; m < 4; ++m) { float* rowp = O + (size_t)(row0 + ai * HALF + m * 16) * ldc + col0;
#pragma unroll
                for (int bj = 0; bj < 2; ++bj)
#pragma unroll
                    for (int n = 0; n < 2; ++n) *(f32x4*)(rowp + bj * HALF + n * 16) = acc[ai][bj][m][n] * scale; }
    }
};

template <class Epi, class Sched, bool ALIGN_EPI>
__device__ __forceinline__ void gemm_phase(LAS unsigned char* lds, const Gemm g, const Sched& S, const Epi& E) {
    int tid_l = threadIdx.x; asm volatile("" : "+v"(tid_l));
    const int tid = tid_l, wid = __builtin_amdgcn_readfirstlane(tid >> 6), lane = tid & 63, wr = wid >> 2, wc = wid & 3, fr = lane & 15, fq = lane >> 4;
    const int K = g.K, nt = K / BK;
    unsigned voffA[2], voffB[2];
#pragma unroll
    for (int i = 0; i < 2; ++i) { int R, C; stage_rc(tid * 16 + i * 8192, R, C); const int Rb = Epi::PERM ? ((R & ~31) + perm32(R & 31)) : R;
        voffA[i] = (unsigned)(R * g.lda + C) * 2u; voffB[i] = (unsigned)(Rb * g.ldb + C) * 2u; }
    const size_t kstep = (size_t)(BK * 2);
    const size_t hstepA = (size_t)HALF * g.lda * 2, hstepB = (size_t)HALF * g.ldb * 2;
    const size_t tstepA = 2 * hstepA, tstepB = 2 * hstepB;
    const unsigned ldsw = (unsigned)wid * 1024u;
    const int aoff = lds_byte(wr * 64 + fr, fq * 8), boff = lds_byte(wc * 32 + fr, fq * 8);
#define PG8_SA(b, h) (((b) * 2 + (h)) * HTB)
#define PG8_SB(b, h) ((4 + (b) * 2 + (h)) * HTB)
#define PG8_STAGE(bufoff, gbase, voff) do { _Pragma("unroll") for (int _i = 0; _i < 2; ++_i) \
        __builtin_amdgcn_global_load_lds((const unsigned*)((const char*)(gbase) + (voff)[_i]), (LAS unsigned*)(lds + (bufoff) + ldsw + _i * 8192), 16, 0, 0); } while (0)
#define PG8_LDA(dst, b, h) do { _Pragma("unroll") for (int m = 0; m < 4; ++m) _Pragma("unroll") for (int k = 0; k < 2; ++k) dst[m][k] = *(const LAS bf16x8*)(lds + PG8_SA(b, h) + aoff + m * 2048 + k * 1024); } while (0)
#define PG8_LDB(dst, b, h) do { _Pragma("unroll") for (int n = 0; n < 2; ++n) _Pragma("unroll") for (int k = 0; k < 2; ++k) dst[n][k] = *(const LAS bf16x8*)(lds + PG8_SB(b, h) + boff + n * 2048 + k * 1024); } while (0)
#define PG8_MMA(ai, bj, At, Bt) do { __builtin_amdgcn_s_setprio(1); _Pragma("unroll") for (int m = 0; m < 4; ++m) _Pragma("unroll") for (int n = 0; n < 2; ++n) _Pragma("unroll") for (int k = 0; k < 2; ++k) \
        acc[ai][bj][m][n] = __builtin_amdgcn_mfma_f32_16x16x32_bf16(Bt[n][k], At[m][k], acc[ai][bj][m][n], 0, 0, 0); __builtin_amdgcn_s_setprio(0); } while (0)
#define PG8_WAIT_V(n) asm volatile("s_waitcnt vmcnt(" #n ")" ::: "memory")
#define PG8_WAIT_L(n) asm volatile("s_waitcnt lgkmcnt(" #n ")" ::: "memory")
#define PG8_BAR __builtin_amdgcn_s_barrier()
#define PG8_SCHED __builtin_amdgcn_sched_barrier(0)
    Unit cur, nxt; int ui = 0;
    if (!S.next(0, cur)) return;
    f32x4 acc[2][2][4][2];
#pragma unroll
    for (int a = 0; a < 2; ++a)
#pragma unroll
        for (int b = 0; b < 2; ++b)
#pragma unroll
            for (int m = 0; m < 4; ++m)
#pragma unroll
                for (int n = 0; n < 2; ++n) acc[a][b][m][n] = (f32x4){0.f, 0.f, 0.f, 0.f};
    bf16x8 At[4][2], B0[2][2], B1[2][2];
    const char* cA = (const char*)g.A + (size_t)cur.pm * tstepA; const char* cB = (const char*)g.Bt + (size_t)cur.pn * tstepB;
    PG8_STAGE(PG8_SB(0, 0), cB, voffB); PG8_STAGE(PG8_SB(0, 1), cB + hstepB, voffB); PG8_STAGE(PG8_SA(0, 0), cA, voffA); PG8_STAGE(PG8_SA(0, 1), cA + hstepA, voffA);
    if (wr == 1) PG8_BAR;
    PG8_WAIT_V(2); PG8_BAR;
    PG8_STAGE(PG8_SB(1, 0), cB + kstep, voffB); PG8_STAGE(PG8_SA(1, 0), cA + kstep, voffA); PG8_STAGE(PG8_SB(1, 1), cB + hstepB + kstep, voffB);
    PG8_WAIT_V(6); PG8_BAR;
    for (;;) {
        const bool has_next = S.next(ui + 1, nxt);
        const char* nA = has_next ? (const char*)g.A + (size_t)nxt.pm * tstepA : cA; const char* nB = has_next ? (const char*)g.Bt + (size_t)nxt.pn * tstepB : cB;
        for (int t = 0; t < nt; t += 2) {
            const bool last = (t == nt - 2);
            const char* a1 = cA + (size_t)(t + 1) * kstep;
            const char* a2 = last ? nA : cA + (size_t)(t + 2) * kstep; const char* b2 = last ? nB : cB + (size_t)(t + 2) * kstep;
            const char* a3 = a2 + kstep; const char* b3 = b2 + kstep;
            PG8_LDB(B0, 0, 0); PG8_LDB(B1, 0, 1); PG8_SCHED; PG8_LDA(At, 0, 0); PG8_STAGE(PG8_SA(1, 1), a1 + hstepA, voffA);
            PG8_WAIT_V(8); PG8_WAIT_L(0); PG8_BAR; PG8_MMA(0, 0, At, B0); PG8_MMA(0, 1, At, B1); PG8_BAR; PG8_SCHED;
            PG8_LDA(At, 0, 1); PG8_STAGE(PG8_SB(0, 0), b2, voffB); PG8_STAGE(PG8_SB(0, 1), b2 + hstepB, voffB); PG8_STAGE(PG8_SA(0, 0), a2, voffA);
            PG8_WAIT_V(8); PG8_WAIT_L(0); PG8_BAR; PG8_MMA(1, 0, At, B0); PG8_MMA(1, 1, At, B1); PG8_BAR; PG8_SCHED;
            PG8_LDB(B0, 1, 0); PG8_LDB(B1, 1, 1); PG8_SCHED; PG8_LDA(At, 1, 0); PG8_STAGE(PG8_SA(0, 1), a2 + hstepA, voffA);
            PG8_WAIT_V(8); PG8_WAIT_L(0); PG8_BAR; PG8_MMA(0, 0, At, B0); PG8_MMA(0, 1, At, B1); PG8_BAR; PG8_SCHED;
            PG8_LDA(At, 1, 1); PG8_STAGE(PG8_SB(1, 0), b3, voffB); PG8_STAGE(PG8_SB(1, 1), b3 + hstepB, voffB); PG8_STAGE(PG8_SA(1, 0), a3, voffA);
            PG8_WAIT_V(8); PG8_WAIT_L(0); PG8_BAR; PG8_MMA(1, 0, At, B0); PG8_MMA(1, 1, At, B1); PG8_BAR; PG8_SCHED;
        }
        if constexpr (ALIGN_EPI) { if (wr == 0) PG8_BAR; }
        E(acc, cur, wr, wc, fr, fq);
        if (!has_next) break;
#pragma unroll
        for (int a = 0; a < 2; ++a)
#pragma unroll
            for (int b = 0; b < 2; ++b)
#pragma unroll
                for (int m = 0; m < 4; ++m)
#pragma unroll
                    for (int n = 0; n < 2; ++n) acc[a][b][m][n] = (f32x4){0.f, 0.f, 0.f, 0.f};
        cur = nxt; cA = nA; cB = nB; ++ui;
        if constexpr (ALIGN_EPI) { if (wr == 1) PG8_BAR; }
    }
    PG8_WAIT_V(0);
    if constexpr (!ALIGN_EPI) { if (wr == 0) PG8_BAR; }
    PG8_BAR;
#undef PG8_SA
#undef PG8_SB
#undef PG8_STAGE
#undef PG8_LDA
#undef PG8_LDB
#undef PG8_MMA
#undef PG8_WAIT_V
#undef PG8_WAIT_L
#undef PG8_BAR
#undef PG8_SCHED
}
}

namespace attn_body {
using bf16 = __hip_bfloat16;
using s16x4 = __attribute__((ext_vector_type(4))) short;
using f32x16 = __attribute__((ext_vector_type(16))) float;
constexpr int NW = 8, QBLK = 32, QB = QBLK * NW, KVBLK = 64;
__device__ __forceinline__ int crow(int r, int hi) { return (r & 3) + 8 * (r >> 2) + 4 * hi; }
#define SBAR() __builtin_amdgcn_sched_barrier(0)
constexpr int NSLOT = 3, SLOTB = 8192;
constexpr int LDS_K = 0, LDS_V = NSLOT * SLOTB, LDS_WS = 2 * NSLOT * SLOTB, LDS_OST = LDS_WS + NW * 64 * 4, LDS_BYTES = LDS_OST + NW * 4096;
constexpr float C2 = 0.125f * 1.4426950408889634f;
__device__ __forceinline__ void glds16(const void* gsrc, unsigned lds_dst) { unsigned keep;
  asm volatile("s_mov_b32 %0, m0\n\ts_mov_b32 m0, %2\n\ts_nop 0\n\tglobal_load_lds_dwordx4 %1, off\n\ts_mov_b32 m0, %0" : "=&s"(keep) : "v"(gsrc), "s"(lds_dst) : "memory"); }
__device__ __forceinline__ float max3f(float a, float b, float c) { float r; asm("v_max3_f32 %0, %1, %2, %3" : "=v"(r) : "v"(a), "v"(b), "v"(c)); return r; }
__device__ __forceinline__ float max2f(float a, float b) { float r; asm("v_max_f32_e32 %0, %1, %2" : "=v"(r) : "v"(a), "v"(b)); return r; }
__device__ __forceinline__ float fadd_s(float a, float b) { float r; asm("v_add_f32_e32 %0, %1, %2" : "=v"(r) : "v"(a), "v"(b)); return r; }
__device__ __forceinline__ float fsub_s(float a, float b) { float r; asm("v_sub_f32_e32 %0, %1, %2" : "=v"(r) : "v"(a), "v"(b)); return r; }
typedef float f32x2_t __attribute__((ext_vector_type(2))); typedef __bf16 bf16x2_t __attribute__((ext_vector_type(2)));
__device__ __forceinline__ unsigned cvtpk_s(float lo, float hi) { f32x2_t v = {lo, hi}; bf16x2_t b = __builtin_convertvector(v, bf16x2_t); return __builtin_bit_cast(unsigned, b); }
#define WAIT_BAR(N) asm volatile("s_waitcnt vmcnt(" #N ") lgkmcnt(0)\n\ts_barrier" ::: "memory")

__device__ __forceinline__ void qkt(f32x16& p0, f32x16& p1, const char* Kslot, const bf16x8* qr, const f32x16& negm, int r32, int hi) {
  const char* kb = Kslot + hi * 1024 + r32 * 16;
  #pragma unroll
  for (int d0 = 0; d0 < 4; ++d0) {
    const bf16x8 b0 = *reinterpret_cast<const bf16x8*>(kb + d0 * 2048);
    const bf16x8 b1 = *reinterpret_cast<const bf16x8*>(kb + d0 * 2048 + 512);
    if (d0 == 0) { p0 = __builtin_amdgcn_mfma_f32_32x32x16_bf16(b0, qr[0], negm, 0, 0, 0); p1 = __builtin_amdgcn_mfma_f32_32x32x16_bf16(b1, qr[0], negm, 0, 0, 0); }
    else { p0 = __builtin_amdgcn_mfma_f32_32x32x16_bf16(b0, qr[d0], p0, 0, 0, 0); p1 = __builtin_amdgcn_mfma_f32_32x32x16_bf16(b1, qr[d0], p1, 0, 0, 0); } }
}
typedef __attribute__((address_space(3))) const char* lds_cptr;
typedef short v4i16_t __attribute__((ext_vector_type(4)));
__device__ __forceinline__ void kload8(bf16x8* kf, lds_cptr kp) {
  kf[0] = *(const __attribute__((address_space(3))) bf16x8*)(kp);        kf[1] = *(const __attribute__((address_space(3))) bf16x8*)(kp + 512);
  kf[2] = *(const __attribute__((address_space(3))) bf16x8*)(kp + 2048); kf[3] = *(const __attribute__((address_space(3))) bf16x8*)(kp + 2560);
  kf[4] = *(const __attribute__((address_space(3))) bf16x8*)(kp + 4096); kf[5] = *(const __attribute__((address_space(3))) bf16x8*)(kp + 4608);
  kf[6] = *(const __attribute__((address_space(3))) bf16x8*)(kp + 6144); kf[7] = *(const __attribute__((address_space(3))) bf16x8*)(kp + 6656);
}
__device__ __forceinline__ void kload2(bf16x8* kf, lds_cptr kp, int j) { kf[2 * j] = *(const __attribute__((address_space(3))) bf16x8*)(kp + j * 2048); kf[2 * j + 1] = *(const __attribute__((address_space(3))) bf16x8*)(kp + j * 2048 + 512); }
__device__ __forceinline__ s16x4 vtr(lds_cptr p) { return __builtin_bit_cast(s16x4, __builtin_amdgcn_ds_read_tr16_b64_v4i16((__attribute__((address_space(3))) v4i16_t*)p)); }
__device__ __forceinline__ float rowmax(const f32x16& p0, const f32x16& p1) {
  float a = max3f(p0[0], p0[1], p1[0]), b = max3f(p0[2], p0[3], p1[1]); a = max3f(a, p1[2], p1[3]);
  #pragma unroll
  for (int r = 4; r < 16; r += 4) { a = max3f(a, p0[r], p0[r + 1]); b = max3f(b, p0[r + 2], p0[r + 3]); a = max3f(a, p1[r], p1[r + 1]); b = max3f(b, p1[r + 2], p1[r + 3]); }
  const float m = max2f(a, b);
  auto rr = __builtin_amdgcn_permlane32_swap(__float_as_uint(m), __float_as_uint(m), false, false);
  return max2f(__uint_as_float(rr[0]), __uint_as_float(rr[1]));
}
__device__ __forceinline__ void pv(f32x16* o, int vb, bf16x8 pa0, bf16x8 pa1, bf16x8 pa2, bf16x8 pa3) {
  #pragma unroll
  for (int d0 = 0; d0 < 2; ++d0) { s16x4 lo[4], hi[4];
    #pragma unroll
    for (int ks = 0; ks < 4; ++ks) {
      asm volatile("ds_read_b64_tr_b16 %0,%1 offset:%c2" : "=&v"(lo[ks]) : "v"(vb), "i"(d0 * 4096 + ks * 1024) : "memory");
      asm volatile("ds_read_b64_tr_b16 %0,%1 offset:%c2" : "=&v"(hi[ks]) : "v"(vb), "i"(d0 * 4096 + ks * 1024 + 512) : "memory"); }
    asm volatile("s_waitcnt lgkmcnt(0)" ::: "memory"); SBAR();
    #define PK(k) (bf16x8){lo[k][0], lo[k][1], lo[k][2], lo[k][3], hi[k][0], hi[k][1], hi[k][2], hi[k][3]}
    o[d0] = __builtin_amdgcn_mfma_f32_32x32x16_bf16(pa0, PK(0), o[d0], 0, 0, 0);
    o[d0] = __builtin_amdgcn_mfma_f32_32x32x16_bf16(pa1, PK(1), o[d0], 0, 0, 0);
    o[d0] = __builtin_amdgcn_mfma_f32_32x32x16_bf16(pa2, PK(2), o[d0], 0, 0, 0);
    o[d0] = __builtin_amdgcn_mfma_f32_32x32x16_bf16(pa3, PK(3), o[d0], 0, 0, 0);
    #undef PK
  }
}

template <int THRL> __device__ __forceinline__ void attn_unit(int b, int h, int qb, const bf16* Z, bf16* O, const float* gq, const float* ropec, const float* ropes, char* shm) {
  int tid_l = threadIdx.x; asm volatile("" : "+v"(tid_l));
  const int tid = tid_l, lane = tid & 63, r32 = lane & 31, hi = lane >> 5; const int wid = __builtin_amdgcn_readfirstlane(tid >> 6);
  const long rowbase = (long)b * SEQ; const int q0 = qb * QB; const int kvh = h >> 2;
  const bf16* Qw = Z + (rowbase + q0 + wid * QBLK) * ZP + ZC_Q + h * 64;
  const bf16* Kh = Z + rowbase * ZP + ZC_K + kvh * 64, *Vh = Z + rowbase * ZP + ZC_VA + kvh * 64;
  const unsigned lds0 = (unsigned)(uintptr_t)shm;
  float* wsf = (float*)(shm + LDS_WS) + wid * 64;
  const bf16* ksrc = Kh + (long)lane * ZP + wid * 8;
  const bf16* vsrc = Vh + (long)(16 * (wid & 3) + (lane >> 2)) * ZP + (wid >> 2) * 32 + (lane & 3) * 8;
  const unsigned kdst = lds0 + LDS_K + wid * 1024, vdst = lds0 + LDS_V + wid * 1024;
  #define DMA_K(t, slot) glds16(ksrc + (long)(t) * KVBLK * ZP, (unsigned)__builtin_amdgcn_readfirstlane(kdst + (slot)))
  #define DMA_V(t, slot) glds16(vsrc + (long)(t) * KVBLK * ZP, (unsigned)__builtin_amdgcn_readfirstlane(vdst + (slot)))
  const int vb0 = (int)(lds0 + LDS_V) + ((lane >> 4) & 1) * 32 + (lane & 3) * 8 + (4 * hi + ((lane & 15) >> 2)) * 64;
  const char* Kbase = shm + LDS_K; bf16x8 kf[8];
  const lds_cptr shm3 = (lds_cptr)shm; const lds_cptr kp0 = shm3 + LDS_K + hi * 1024 + r32 * 16; const lds_cptr vp0 = shm3 + LDS_V + ((lane >> 4) & 1) * 32 + (lane & 3) * 8 + (4 * hi + ((lane & 15) >> 2)) * 64;
  constexpr int NT = SEQ / KVBLK;
  DMA_K(0, 0); DMA_V(0, 0); DMA_K(1, SLOTB);
  bf16x8 qr[4];
  {
    u32x4 raw[4];
    #pragma unroll
    for (int d0 = 0; d0 < 4; ++d0) raw[d0] = *reinterpret_cast<const u32x4*>(&Qw[(long)r32 * ZP + d0 * 16 + hi * 8]);
    float ss = 0.f;
    #pragma unroll
    for (int d0 = 0; d0 < 4; ++d0)
      #pragma unroll
      for (int e = 0; e < 4; ++e) { const float a = bflo(raw[d0][e]), c = bfhi(raw[d0][e]); ss += a * a + c * c; }
    ss += __shfl_xor(ss, 32);
    const float rinv = 1.0f / sqrtf(ss * (1.0f / 64.0f) + EPS);
    const int pos = q0 + wid * QBLK + r32, prow = pos >> 6, pcol = pos & 63;
    #pragma unroll
    for (int hf = 0; hf < 2; ++hf) {
      const int pp = hf ? pcol : prow;
      u32x4 w1, w2;
      #pragma unroll
      for (int e2 = 0; e2 < 4; ++e2) {
        float o1[2], o2[2];
        #pragma unroll
        for (int s = 0; s < 2; ++s) { const int e = 2 * e2 + s; const int i = 8 * hi + e;
          const float cs = ropec[pp * 16 + i], sn = ropes[pp * 16 + i];
          const unsigned wa = raw[2 * hf][e2], wb = raw[2 * hf + 1][e2];
          const float x1 = (s ? bfhi(wa) : bflo(wa)) * rinv * gq[32 * hf + i], x2 = (s ? bfhi(wb) : bflo(wb)) * rinv * gq[32 * hf + 16 + i];
          o1[s] = (x1 * cs - x2 * sn) * C2; o2[s] = (x2 * cs + x1 * sn) * C2; }
        w1[e2] = cvtpk_s(o1[0], o1[1]); w2[e2] = cvtpk_s(o2[0], o2[1]); }
      qr[2 * hf] = __builtin_bit_cast(bf16x8, w1); qr[2 * hf + 1] = __builtin_bit_cast(bf16x8, w2);
    }
  }
  float mhat = 0.f, l_reg = 0.f; f32x16 o[2]; o[0] = f32x16{}; o[1] = f32x16{}; f32x16 negm = f32x16{}; asm volatile("" : "+v"(negm));
  bool resc = false;
  #define START(P0, P1) do { const float rm = rowmax(P0, P1); resc = false; \
    { const float dl = rm; mhat = fadd_s(mhat, dl); \
      _Pragma("unroll") for (int r = 0; r < 16; ++r) { P0[r] = fsub_s(P0[r], dl); P1[r] = fsub_s(P1[r], dl); } \
      _Pragma("unroll") for (int r = 0; r < 16; ++r) negm[r] = -mhat; asm volatile("" : "+v"(negm)); } \
    _Pragma("unroll") for (int r = 0; r < 16; ++r) P0[r] = __builtin_amdgcn_exp2f(P0[r]); } while (0)
  #define RESC() do { if (resc) { asm volatile("s_waitcnt lgkmcnt(0)" ::: "memory"); \
      _Pragma("unroll") for (int d_ = 0; d_ < 2; ++d_) _Pragma("unroll") for (int r = 0; r < 16; ++r) o[d_][r] *= wsf[crow(r, hi)]; } } while (0)
  f32x16 pA0, pA1, pB0, pB1;
  int sl_prev = 0, sl_cur = 0, sl_next = SLOTB;
  #define ROT() do { sl_prev = sl_cur; sl_cur = sl_next; sl_next = (sl_next == (NSLOT - 1) * SLOTB) ? 0 : sl_next + SLOTB; } while (0)
  DMA_K(2, 2 * SLOTB);
  WAIT_BAR(3);
  qkt(pA0, pA1, Kbase, qr, negm, r32, hi); asm volatile("s_nop 15\n\ts_nop 7" : "+v"(pA0), "+v"(pA1));
  START(pA0, pA1);
  _Pragma("unroll") for (int r = 0; r < 16; ++r) pA1[r] = __builtin_amdgcn_exp2f(pA1[r]);
  WAIT_BAR(0);
  DMA_K(3, 0); DMA_V(1, SLOTB);
  ROT();
  kload8(kf, kp0 + sl_cur);
  WAIT_BAR(2);
  s16x4 vlo[8], vhi[8]; u32x4 pw0, pw1, pw2, pw3;
  #define PKW(P, B) cvtpk_s(P[B], P[B + 1])
  #define PAF(k) __builtin_bit_cast(bf16x8, pw##k)
  #define VFR(i) (bf16x8){vlo[i][0], vlo[i][1], vlo[i][2], vlo[i][3], vhi[i][0], vhi[i][1], vhi[i][2], vhi[i][3]}
  #define PIN(x) asm volatile("" : "+v"(x))
  #define MX3(a, b, c) __builtin_fmaxf(__builtin_fmaxf((a), (b)), (c))
  #define GAPA(MF, A0, A1, A2, A3, W0, W1, PW) do { MF; sacc += A0; sacc += A1; sacc += A2; sacc += A3; PIN(sacc); W0; W1; PIN(PW); SBAR(); } while (0)
  #define EX(v) __builtin_amdgcn_exp2f(v)
  #define GAPB(MF, X, B) do { MF; X[B] = EX(X[B]); X[B + 1] = EX(X[B + 1]); X[B + 2] = EX(X[B + 2]); X[B + 3] = EX(X[B + 3]); PIN(X); SBAR(); } while (0)
  #define VRD(i) do { vlo[i] = vtr(vp_ + (((i) >> 2) * 4096 + ((i) & 3) * 1024)); vhi[i] = vtr(vp_ + (((i) >> 2) * 4096 + ((i) & 3) * 1024 + 512)); } while (0)
  #define KRD(G, j) do { if (G) { kload2(kf, kp0 + sl_next, j); SBAR(); } } while (0)
  #define STEP(C0, C1, P0, P1, t, GK, GV, GL) do { SBAR(); \
    const lds_cptr vp_ = vp0 + sl_prev; \
    VRD(0); SBAR(); float sacc = (P0[0] + P0[1]); \
    GAPA(C0 = __builtin_amdgcn_mfma_f32_32x32x16_bf16(kf[0], qr[0], negm, 0, 0, 0), P0[2], P0[3], P0[4], P0[5],     pw0[0] = PKW(P0, 0), pw0[1] = PKW(P0, 2), pw0); \
    VRD(4); SBAR(); GAPA(C1 = __builtin_amdgcn_mfma_f32_32x32x16_bf16(kf[1], qr[0], negm, 0, 0, 0), P0[6], P0[7], P0[8], P0[9],     pw0[2] = PKW(P0, 4), pw0[3] = PKW(P0, 6), pw0); \
    VRD(1); SBAR(); GAPA(C0 = __builtin_amdgcn_mfma_f32_32x32x16_bf16(kf[2], qr[1], C0, 0, 0, 0),   P0[10], P0[11], P0[12], P0[13], pw1[0] = PKW(P0, 8), pw1[1] = PKW(P0, 10), pw1); \
    VRD(5); SBAR(); GAPA(C1 = __builtin_amdgcn_mfma_f32_32x32x16_bf16(kf[3], qr[1], C1, 0, 0, 0),   P0[14], P0[15], P1[0], P1[1],   pw1[2] = PKW(P0, 12), pw1[3] = PKW(P0, 14), pw1); \
    VRD(2); SBAR(); GAPA(C0 = __builtin_amdgcn_mfma_f32_32x32x16_bf16(kf[4], qr[2], C0, 0, 0, 0),   P1[2], P1[3], P1[4], P1[5],     pw2[0] = PKW(P1, 0), pw2[1] = PKW(P1, 2), pw2); \
    VRD(6); SBAR(); GAPA(C1 = __builtin_amdgcn_mfma_f32_32x32x16_bf16(kf[5], qr[2], C1, 0, 0, 0),   P1[6], P1[7], P1[8], P1[9],     pw2[2] = PKW(P1, 4), pw2[3] = PKW(P1, 6), pw2); \
    VRD(3); SBAR(); GAPA(C0 = __builtin_amdgcn_mfma_f32_32x32x16_bf16(kf[6], qr[3], C0, 0, 0, 0),   P1[10], P1[11], P1[12], P1[13], pw3[0] = PKW(P1, 8), pw3[1] = PKW(P1, 10), pw3); \
    VRD(7); SBAR(); GAPA(C1 = __builtin_amdgcn_mfma_f32_32x32x16_bf16(kf[7], qr[3], C1, 0, 0, 0),   P1[14], P1[15], 0.f, 0.f,       pw3[2] = PKW(P1, 12), pw3[3] = PKW(P1, 14), pw3); \
    l_reg += sacc; \
    if (GK) { DMA_K((t) + 3, sl_cur); } if (GV) { DMA_V((t) + 1, sl_next); } \
    { float a = MX3(C0[0], C0[1], C1[0]), b = MX3(C0[2], C0[3], C1[1]); a = MX3(a, C1[2], C1[3]); \
      _Pragma("unroll") for (int r = 4; r < 16; r += 4) { a = MX3(a, C0[r], C0[r + 1]); b = MX3(b, C0[r + 2], C0[r + 3]); a = MX3(a, C1[r], C1[r + 1]); b = MX3(b, C1[r + 2], C1[r + 3]); } \
      float rm = __builtin_fmaxf(a, b); { auto rr = __builtin_amdgcn_permlane32_swap(__float_as_uint(rm), __float_as_uint(rm), false, false); rm = __builtin_fmaxf(__uint_as_float(rr[0]), __uint_as_float(rr[1])); } \
      resc = false; \
      if (__builtin_expect(__any(rm > (float)THRL), 0)) { const float dl = __builtin_fmaxf(rm, 0.f); mhat += dl; \
        _Pragma("unroll") for (int r = 0; r < 16; ++r) { C0[r] -= dl; C1[r] -= dl; } \
        _Pragma("unroll") for (int r = 0; r < 16; ++r) negm[r] = -mhat; asm volatile("" : "+v"(negm)); \
        const float f = __builtin_amdgcn_exp2f(-dl); l_reg *= f; if (hi == 0) wsf[r32] = f; resc = true; } } \
    SBAR(); \
    GAPB(o[0] = __builtin_amdgcn_mfma_f32_32x32x16_bf16(PAF(0), VFR(0), o[0], 0, 0, 0), C0, 0); \
    GAPB(o[1] = __builtin_amdgcn_mfma_f32_32x32x16_bf16(PAF(0), VFR(4), o[1], 0, 0, 0), C0, 4); \
    KRD(GL, 0); GAPB(o[0] = __builtin_amdgcn_mfma_f32_32x32x16_bf16(PAF(1), VFR(1), o[0], 0, 0, 0), C0, 8); \
    KRD(GL, 1); GAPB(o[1] = __builtin_amdgcn_mfma_f32_32x32x16_bf16(PAF(1), VFR(5), o[1], 0, 0, 0), C0, 12); \
    KRD(GL, 2); GAPB(o[0] = __builtin_amdgcn_mfma_f32_32x32x16_bf16(PAF(2), VFR(2), o[0], 0, 0, 0), C1, 0); \
    KRD(GL, 3); GAPB(o[1] = __builtin_amdgcn_mfma_f32_32x32x16_bf16(PAF(2), VFR(6), o[1], 0, 0, 0), C1, 4); \
    GAPB(o[0] = __builtin_amdgcn_mfma_f32_32x32x16_bf16(PAF(3), VFR(3), o[0], 0, 0, 0), C1, 8); \
    GAPB(o[1] = __builtin_amdgcn_mfma_f32_32x32x16_bf16(PAF(3), VFR(7), o[1], 0, 0, 0), C1, 12); \
    } while (0)
  int t = 1;
  for (; t + 5 < NT; t += 2) {
    STEP(pB0, pB1, pA0, pA1, t, true, true, true);     WAIT_BAR(2); RESC(); ROT();
    STEP(pA0, pA1, pB0, pB1, t + 1, true, true, true); WAIT_BAR(2); RESC(); ROT();
  }
  #define ENDW(tt) do { if ((tt) + 3 < NT) { WAIT_BAR(2); } else if ((tt) + 2 < NT) { WAIT_BAR(1); } else { WAIT_BAR(0); } } while (0)
  for (; t + 1 < NT; t += 2) {
    STEP(pB0, pB1, pA0, pA1, t, (t + 3 < NT), (t + 1 < NT), (t + 1 < NT));         ENDW(t);     RESC(); ROT();
    STEP(pA0, pA1, pB0, pB1, t + 1, (t + 4 < NT), (t + 2 < NT), (t + 2 < NT));     ENDW(t + 1); RESC(); ROT();
  }
  STEP(pB0, pB1, pA0, pA1, NT - 1, false, false, false); RESC();
  { float sacc = pB0[0] + pB0[1]; _Pragma("unroll") for (int r = 2; r < 16; ++r) sacc += pB0[r]; _Pragma("unroll") for (int r = 0; r < 16; ++r) sacc += pB1[r]; l_reg += sacc;
    pw0 = (u32x4){PKW(pB0, 0), PKW(pB0, 2), PKW(pB0, 4), PKW(pB0, 6)}; pw1 = (u32x4){PKW(pB0, 8), PKW(pB0, 10), PKW(pB0, 12), PKW(pB0, 14)}; pw2 = (u32x4){PKW(pB1, 0), PKW(pB1, 2), PKW(pB1, 4), PKW(pB1, 6)}; pw3 = (u32x4){PKW(pB1, 8), PKW(pB1, 10), PKW(pB1, 12), PKW(pB1, 14)};
    SBAR(); pv(o, vb0 + sl_cur, PAF(0), PAF(1), PAF(2), PAF(3)); }
  #undef PKW
  #undef PAF
  #undef VFR
  #undef PIN
  #undef MX3
  #undef GAPA
  #undef GAPB
  #undef EX
  #undef VRD
  #undef KRD
  #undef STEP
  #undef ENDW
  { auto rr = __builtin_amdgcn_permlane32_swap(__float_as_uint(l_reg), __float_as_uint(l_reg), false, false); l_reg = __uint_as_float(rr[0]) + __uint_as_float(rr[1]); }
  if (hi == 0) wsf[32 + r32] = l_reg; asm volatile("s_waitcnt lgkmcnt(0)" ::: "memory");
  float rli[16];
  #pragma unroll
  for (int r = 0; r < 16; ++r) rli[r] = __builtin_amdgcn_rcpf(wsf[32 + crow(r, hi)]);
  bf16* Ow = O + (rowbase + q0 + wid * QBLK) * OP + h * 64;
  { bf16* stg = (bf16*)(shm + LDS_OST) + wid * 2048;
    #pragma unroll
    for (int r = 0; r < 16; ++r) { const int orow = crow(r, hi);
      #pragma unroll
      for (int d0 = 0; d0 < 2; ++d0) stg[orow * 64 + d0 * 32 + r32] = __float2bfloat16(o[d0][r] * rli[r]); }
    asm volatile("s_waitcnt lgkmcnt(0)" ::: "memory");
    #pragma unroll
    for (int i = 0; i < 4; ++i) { const int row = i * 8 + (lane >> 3), ch = lane & 7; const u32x4 v = *(const u32x4*)(stg + row * 64 + ch * 8); *(u32x4*)(Ow + (long)row * OP + ch * 8) = v; } }
  asm volatile("s_waitcnt lgkmcnt(0)\n\ts_barrier" ::: "memory");
  #undef DMA_K
  #undef DMA_V
  #undef START
  #undef RESC
  #undef ROT
}
#undef SBAR
#undef WAIT_BAR
}

constexpr int RING_BYTES = 131072, LDS_BYTES = 147456;
static_assert(attn_body::LDS_BYTES <= RING_BYTES, "attention scratch");

struct Args { const float* in[16]; float* out; unsigned char* ws; };
enum { I_X = 0, I_GPRE, I_WIN, I_SW, I_SB, I_SG, I_GQ, I_GK, I_GMIX, I_WOUT, I_GPOSTM, I_GPREF, I_WG, I_WU, I_WD, I_GPOSTF };

__device__ __forceinline__ void transpose_item(const float* W, int ldw, int k0, int n0, bf16_t* WT, int ldt, int drow0, LAS float* scr, int lane) {
#pragma unroll 8
    for (int i = 0; i < 32; ++i) { const int kk = 2 * i + (lane >> 5); scr[kk * 33 + (lane & 31)] = W[(size_t)(k0 + kk) * ldw + n0 + (lane & 31)]; }
    asm volatile("s_waitcnt lgkmcnt(0)" ::: "memory");
    const int c = lane & 7;
#pragma unroll
    for (int j = 0; j < 4; ++j) { const int n = (lane >> 3) + 8 * j; const LAS float* s = scr + (8 * c) * 33 + n;
        u32x4 o; o.x = pk2(s[0 * 33], s[1 * 33]); o.y = pk2(s[2 * 33], s[3 * 33]); o.z = pk2(s[4 * 33], s[5 * 33]); o.w = pk2(s[6 * 33], s[7 * 33]);
        *(u32x4*)(WT + (size_t)(drow0 + n) * ldt + k0 + 8 * c) = o; }
    asm volatile("s_waitcnt lgkmcnt(0)" ::: "memory");
}

__device__ __forceinline__ void resnorm_row(const bf16_t* mrow, const float* base, float* out, const float* gpost, const float* gnext, bf16_t* xn, int lane) {
    f32x4 xv[4]; float mv[4][4]; float ss = 0.f;
#pragma unroll
    for (int j = 0; j < 4; ++j) { const u32x2 w = *(const u32x2*)(mrow + 256 * j + 4 * lane); xv[j] = *(const f32x4*)(base + 256 * j + 4 * lane);
        mv[j][0] = bflo(w.x); mv[j][1] = bfhi(w.x); mv[j][2] = bflo(w.y); mv[j][3] = bfhi(w.y);
        ss += (mv[j][0] * mv[j][0] + mv[j][1] * mv[j][1]) + (mv[j][2] * mv[j][2] + mv[j][3] * mv[j][3]); }
    const float r1 = 1.0f / sqrtf(wave_sum(ss) * (1.0f / 1024.0f) + EPS); float s2 = 0.f;
#pragma unroll
    for (int j = 0; j < 4; ++j) { const f32x4 g = *(const f32x4*)(gpost + 256 * j + 4 * lane);
#pragma unroll
        for (int e = 0; e < 4; ++e) { xv[j][e] += mv[j][e] * r1 * g[e]; s2 += xv[j][e] * xv[j][e]; }
        *(f32x4*)(out + 256 * j + 4 * lane) = xv[j]; }
    if (xn) { const float r2 = 1.0f / sqrtf(wave_sum(s2) * (1.0f / 1024.0f) + EPS);
#pragma unroll
        for (int j = 0; j < 4; ++j) { const f32x4 g = *(const f32x4*)(gnext + 256 * j + 4 * lane);
            u32x2 w; w.x = pk2(xv[j][0] * r2 * g[0], xv[j][1] * r2 * g[1]); w.y = pk2(xv[j][2] * r2 * g[2], xv[j][3] * r2 * g[3]);
            *(u32x2*)(xn + 256 * j + 4 * lane) = w; } }
}

__device__ __forceinline__ void sgu_unit(int unit, const bf16_t* Z, const float* Ws, const float* bs, const float* gv, const float* gmix, bf16_t* Y, LAS unsigned char* lds, int tid) {
    const int lane = tid & 63, w = __builtin_amdgcn_readfirstlane(tid >> 6), fr = lane & 15, fq = lane >> 4;
    const int row0 = unit * 128;
    constexpr int VTP = 272;
    LAS unsigned char* VT = lds; LAS float* SS = (LAS float*)(lds + 256 * VTP);
    {
        const int r = tid >> 2, qd = tid & 3;
        const bf16_t* vp = Z + (size_t)(row0 + r) * ZP + ZC_V + 64 * qd;
        u32x4 raw[8]; float s = 0.f;
#pragma unroll
        for (int j = 0; j < 8; ++j) { raw[j] = *(const u32x4*)(vp + 8 * j);
#pragma unroll
            for (int e = 0; e < 4; ++e) s += bflo(raw[j][e]) + bfhi(raw[j][e]); }
        s += __shfl_xor(s, 1); s += __shfl_xor(s, 2);
        const float mu = s * (1.0f / 256.0f); float q = 0.f;
#pragma unroll
        for (int j = 0; j < 8; ++j)
#pragma unroll
            for (int e = 0; e < 4; ++e) { const float a = bflo(raw[j][e]) - mu, b = bfhi(raw[j][e]) - mu; q += a * a + b * b; }
        q += __shfl_xor(q, 1); q += __shfl_xor(q, 2);
        const float rstd = 1.0f / sqrtf(q * (1.0f / 256.0f) + EPS);
#pragma unroll
        for (int j = 0; j < 8; ++j)
#pragma unroll
            for (int e = 0; e < 4; ++e) { const int c = 64 * qd + 8 * j + 2 * e;
                const float a = (bflo(raw[j][e]) - mu) * rstd * gv[c], b = (bfhi(raw[j][e]) - mu) * rstd * gv[c + 1];
                *(LAS bf16_t*)(VT + c * VTP + r * 2) = (bf16_t)f2bf(a); *(LAS bf16_t*)(VT + (c + 1) * VTP + r * 2) = (bf16_t)f2bf(b); }
    }
    __syncthreads();
    const int h = w >> 1, cbase = 64 * h + 32 * (w & 1);
    bf16x8 bfr[2][4];
#pragma unroll
    for (int n = 0; n < 2; ++n)
#pragma unroll
        for (int kk = 0; kk < 4; ++kk) bfr[n][kk] = *(const LAS bf16x8*)(VT + (cbase + 16 * n + fr) * VTP + (32 * kk + 8 * fq) * 2);
    f32x4 acc[8][2];
    const float* Wh = Ws + (size_t)h * 128 * 128;
#pragma unroll
    for (int m = 0; m < 8; ++m) {
        acc[m][0] = (f32x4){0.f, 0.f, 0.f, 0.f}; acc[m][1] = (f32x4){0.f, 0.f, 0.f, 0.f};
#pragma unroll
        for (int kk = 0; kk < 4; ++kk) {
            const float* ap = Wh + (size_t)(16 * m + fr) * 128 + 32 * kk + 8 * fq;
            const f32x4 a0 = *(const f32x4*)ap, a1 = *(const f32x4*)(ap + 4);
            u32x4 aw; aw.x = pk2(a0[0], a0[1]); aw.y = pk2(a0[2], a0[3]); aw.z = pk2(a1[0], a1[1]); aw.w = pk2(a1[2], a1[3]);
            const bf16x8 af = __builtin_bit_cast(bf16x8, aw);
            acc[m][0] = __builtin_amdgcn_mfma_f32_16x16x32_bf16(bfr[0][kk], af, acc[m][0], 0, 0, 0);
            acc[m][1] = __builtin_amdgcn_mfma_f32_16x16x32_bf16(bfr[1][kk], af, acc[m][1], 0, 0, 0);
        }
    }
#pragma unroll
    for (int m = 0; m < 8; ++m) { const int p = 16 * m + fr; const float bias = bs[h * 128 + p]; float ss = 0.f;
#pragma unroll
        for (int n = 0; n < 2; ++n) { const int c = cbase + 16 * n + 4 * fq; const u32x2 uw = *(const u32x2*)(Z + (size_t)(row0 + p) * ZP + ZC_U + c);
            f32x4 v = acc[m][n]; v[0] = (v[0] + bias) * bflo(uw.x); v[1] = (v[1] + bias) * bfhi(uw.x); v[2] = (v[2] + bias) * bflo(uw.y); v[3] = (v[3] + bias) * bfhi(uw.y);
            acc[m][n] = v; ss += (v[0] * v[0] + v[1] * v[1]) + (v[2] * v[2] + v[3] * v[3]); }
        ss += __shfl_xor(ss, 16); ss += __shfl_xor(ss, 32);
        if (fq == 0) SS[w * 128 + p] = ss; }
    __syncthreads();
#pragma unroll
    for (int m = 0; m < 8; ++m) { const int p = 16 * m + fr; float tot = 0.f;
#pragma unroll
        for (int ww = 0; ww < 8; ++ww) tot += SS[ww * 128 + p];
        const float rr = 1.0f / sqrtf(tot * (1.0f / 256.0f) + EPS);
#pragma unroll
        for (int n = 0; n < 2; ++n) { const int c = cbase + 16 * n + 4 * fq; const f32x4 g = *(const f32x4*)(gmix + 256 + c); const f32x4 v = acc[m][n];
            u32x2 ow; ow.x = pk2(v[0] * rr * g[0], v[1] * rr * g[1]); ow.y = pk2(v[2] * rr * g[2], v[3] * rr * g[3]);
            *(u32x2*)(Y + (size_t)(row0 + p) * DM + 256 + c) = ow; } }
    __syncthreads();
}

__global__ void __launch_bounds__(NTHR, 2) hybrid_fwd(Args args) {
    extern __shared__ __attribute__((aligned(16))) unsigned char lds_raw[];
    cg::grid_group grid = cg::this_grid();
    LAS unsigned char* lds = (LAS unsigned char*)lds_raw;
    const int tid = threadIdx.x, lane = tid & 63, wave = __builtin_amdgcn_readfirstlane(tid >> 6);
    const int G = gridDim.x; const int bx = blockIdx.x; const int vcu = (G % 8 == 0) ? (bx % 8) * (G / 8) + bx / 8 : bx;
    const int gw = vcu * NWAVES + wave, NGW = G * NWAVES;
    unsigned char* ws = args.ws;
    float* ropec = (float*)(ws + WS_CTL); float* ropes = ropec + 1024;
    bf16_t* XN = (bf16_t*)(ws + WS_XN); bf16_t* MB = (bf16_t*)(ws + WS_MB); float* PP = (float*)(ws + WS_MB);
    bf16_t* HB = (bf16_t*)(ws + WS_H); bf16_t* Zm = (bf16_t*)(ws + WS_Z); bf16_t* ZFt = (bf16_t*)(ws + WS_ZF); bf16_t* OB = (bf16_t*)(ws + WS_O); bf16_t* Y = (bf16_t*)(ws + WS_Y);
    bf16_t* DFTM = (bf16_t*)(ws + WS_DFT);
    const float* x_in = args.in[I_X]; float* out = args.out;

    {
        LAS float* scr = (LAS float*)(lds + wave * 16384);
        constexpr int IT_IN = 16 * 40, IT_OUT = 16 * 32, IT_G = 16 * 88, IT_D = 44 * 32, IT_L = IT_IN + IT_OUT + 2 * IT_G + IT_D;
        for (int it = gw; it < DEPTH * IT_L; it += NGW) {
            const int l = it / IT_L; int r = it % IT_L; unsigned char* wl = ws + WS_W + (size_t)l * WL_SIZE;
            if (r < IT_IN) { const int kb = r / 40, nb = r % 40; transpose_item(args.in[I_WIN] + (size_t)l * DM * DIN, DIN, 64 * kb, 256 + 32 * nb, (bf16_t*)(wl + WL_IN), DM, 32 * nb, scr, lane); continue; } r -= IT_IN;
            if (r < IT_OUT) { const int kb = r / 32, nb = r % 32; transpose_item(args.in[I_WOUT] + (size_t)l * DM * DM, DM, 64 * kb, 32 * nb, (bf16_t*)(wl + WL_OUT), DM, 32 * nb, scr, lane); continue; } r -= IT_OUT;
            if (r < 2 * IT_G) { const int up = r >= IT_G; if (up) r -= IT_G; const int kb = r / 88, nb = r % 88; const int n0 = 32 * nb;
                transpose_item(args.in[up ? I_WU : I_WG] + (size_t)l * DM * DFF, DFF, 64 * kb, n0, (bf16_t*)(wl + WL_GU), DM, 256 * (n0 >> 7) + (n0 & 127) + (up ? 128 : 0), scr, lane); continue; } r -= 2 * IT_G;
            { const int kb = r / 32, nb = r % 32; transpose_item(args.in[I_WD] + (size_t)l * DFF * DM, DM, 64 * kb, 32 * nb, (bf16_t*)(wl + WL_DN), DFF, 32 * nb, scr, lane); }
        }
        {
            float sn64, cs64; sincospif((float)lane * (1.0f / 32.0f), &sn64, &cs64);
            for (int it = gw; it < DEPTH * 4096; it += NGW) {
                const int l = it >> 12, k = (it & 4095) >> 2, g = it & 3;
                const float wv = args.in[I_WIN][(size_t)l * DM * DIN + (size_t)k * DIN + 64 * g + lane];
                float ac = 0.f, as = 0.f;
#pragma unroll 8
                for (int c = 0; c < 64; ++c) { const float wc = __shfl(wv, c); const int idx = (c * lane) & 63; ac += wc * __shfl(cs64, idx); as += wc * __shfl(sn64, idx); }
                bf16_t* wf = (bf16_t*)(ws + WS_W + (size_t)l * WL_SIZE + WL_F);
                wf[(size_t)(64 * g + lane) * DM + k] = (bf16_t)f2bf(ac); wf[(size_t)(256 + 64 * g + lane) * DM + k] = (bf16_t)f2bf(as);
            }
        }
        if (bx == 0) { for (int i = tid; i < 1024; i += NTHR) { const int p = i >> 4, j = i & 15; const float fr_ = powf(10000.0f, -(float)j / 16.0f); const float ang = (float)p * fr_; ropec[i] = cosf(ang); ropes[i] = sinf(ang); } }
        { int lane_ = lane; asm volatile("" : "+v"(lane_)); const int lane = lane_;
        for (int m = gw; m < MTOK; m += NGW) {
            const float* xr = x_in + (size_t)m * DM; f32x4 v[4]; float ss = 0.f;
#pragma unroll
            for (int j = 0; j < 4; ++j) { v[j] = *(const f32x4*)(xr + 256 * j + 4 * lane); ss += (v[j][0] * v[j][0] + v[j][1] * v[j][1]) + (v[j][2] * v[j][2] + v[j][3] * v[j][3]); }
            const float r = 1.0f / sqrtf(wave_sum(ss) * (1.0f / 1024.0f) + EPS);
#pragma unroll
            for (int j = 0; j < 4; ++j) { const f32x4 g = *(const f32x4*)(args.in[I_GPRE] + 256 * j + 4 * lane);
                u32x2 w; w.x = pk2(v[j][0] * r * g[0], v[j][1] * r * g[1]); w.y = pk2(v[j][2] * r * g[2], v[j][3] * r * g[3]);
                *(u32x2*)(XN + (size_t)m * DM + 256 * j + 4 * lane) = w; }
        } }
        __syncthreads();
        {
            LAS unsigned* tab = (LAS unsigned*)lds;
            for (int j = tid; j < 4096; j += NTHR) { float s, c; sincospif((float)j * (1.0f / 2048.0f), &s, &c); tab[j] = f2bf(c) | (f2bf(-s) << 16); }
            __syncthreads();
            for (int it = vcu * NTHR + tid; it < 4096 * 512; it += G * NTHR) { const int k = it >> 9, n0 = (it & 511) * 8;
                unsigned t[8];
#pragma unroll
                for (int e = 0; e < 8; ++e) t[e] = tab[(k * (n0 + e)) & 4095];
                u32x4 cw, sw;
                cw.x = (t[0] & 0xffffu) | (t[1] << 16); cw.y = (t[2] & 0xffffu) | (t[3] << 16); cw.z = (t[4] & 0xffffu) | (t[5] << 16); cw.w = (t[6] & 0xffffu) | (t[7] << 16);
                sw.x = (t[0] >> 16) | (t[1] & 0xffff0000u); sw.y = (t[2] >> 16) | (t[3] & 0xffff0000u); sw.z = (t[4] >> 16) | (t[5] & 0xffff0000u); sw.w = (t[6] >> 16) | (t[7] & 0xffff0000u);
                *(u32x4*)(DFTM + (size_t)k * 4096 + n0) = cw; *(u32x4*)(DFTM + (size_t)4096 * 4096 + (size_t)k * 4096 + n0) = sw; }
            __syncthreads();
        }
    }
    grid.sync();

#pragma unroll 1
    for (int l = 0; l < DEPTH; ++l) {
        unsigned char* wl = ws + WS_W + (size_t)l * WL_SIZE;
        const float* gmix = args.in[I_GMIX] + l * 1024;
        {
            pg8::Gemm g{XN, (const bf16_t*)(wl + WL_IN), DM, DM, DM}; pg8::StaticOrder S; S.init(MTOK, 1280, G, bx);
            pg8::EpiBf16<1> E{Zm, ZP};
            pg8::gemm_phase<pg8::EpiBf16<1>, pg8::StaticOrder, true>(lds, g, S, E);
        }
        {
            pg8::Gemm g{(const bf16_t*)(wl + WL_F), XN, DM, DM, DM}; pg8::StaticOrder S; S.init(512, MTOK, G, G - 1 - bx);
            pg8::EpiBf16<0> E{ZFt, MTOK};
            pg8::gemm_phase<pg8::EpiBf16<0>, pg8::StaticOrder, true>(lds, g, S, E);
        }
        grid.sync();
        {
            const float* gk = args.in[I_GK] + l * 64;
            { int lane_ = lane; asm volatile("" : "+v"(lane_)); const int lane = lane_;
            for (int m = gw; m < MTOK; m += NGW) {
                const int hh = lane >> 5, j = lane & 31, t = j >> 4, i = j & 15;
                bf16_t* kp = Zm + (size_t)m * ZP + ZC_K + hh * 64 + 32 * t + i;
                const float a = bflo((unsigned)kp[0]), b = bflo((unsigned)kp[16]);
                float ss = a * a + b * b;
#pragma unroll
                for (int o = 1; o < 32; o <<= 1) ss += __shfl_xor(ss, o);
                const float r = 1.0f / sqrtf(ss * (1.0f / 64.0f) + EPS);
                const int pos = m & (SEQ - 1), pp = t ? (pos & 63) : (pos >> 6);
                const float cs = ropec[pp * 16 + i], sn = ropes[pp * 16 + i];
                const float x1 = a * r * gk[32 * t + i], x2 = b * r * gk[32 * t + 16 + i];
                kp[0] = (bf16_t)f2bf(x1 * cs - x2 * sn); kp[16] = (bf16_t)f2bf(x2 * cs + x1 * sn);
            } }
            int tid_ = tid; asm volatile("" : "+v"(tid_));
            for (int u = vcu; u < MTOK / 128; u += G)
                sgu_unit(u, Zm, args.in[I_SW] + (size_t)l * 4 * 128 * 128, args.in[I_SB] + l * 512, args.in[I_SG] + l * 256, gmix, Y, lds, tid_);
            for (int u = vcu; u < 256; u += G) {
                const int part = u >> 7, b = (u >> 4) & 7, mt = u & 15;
                pg8::Gemm g{DFTM + (size_t)part * 4096 * 4096, ZFt + (size_t)part * 256 * MTOK + (size_t)b * SEQ, 4096, MTOK, 4096};
                pg8::OneUnit S{mt, 0, 1};
                pg8::EpiF32 E{PP + (size_t)part * MTOK * 256 + (size_t)b * SEQ * 256, 256, 1.0f / 512.0f};
                pg8::gemm_phase<pg8::EpiF32, pg8::OneUnit, false>(lds, g, S, E);
            }
        }
        grid.sync();
        {
            const float* gq = args.in[I_GQ] + l * 64;
            for (int idx = vcu; idx < 1024; idx += G) {
                const int x = (idx & 255) >> 5, j = idx & 31, i = idx >> 8, lu = i * 32 + j, pair = 2 * x + (lu >> 6), wi = lu & 63;
                const int b = pair >> 1, kvh = pair & 1, h = kvh * 4 + (wi >> 4), qb = wi & 15;
                attn_body::attn_unit<8>(b, h, qb, (const attn_body::bf16*)Zm, (attn_body::bf16*)OB, gq, ropec, ropes, (char*)lds_raw);
            }
        }
        grid.sync();
        { int lane_ = lane; asm volatile("" : "+v"(lane_)); const int lane = lane_;
        for (int m = gw; m < MTOK; m += NGW) {
            { const f32x4 p0 = *(const f32x4*)(PP + (size_t)m * 256 + 4 * lane), p1 = *(const f32x4*)(PP + (size_t)MTOK * 256 + (size_t)m * 256 + 4 * lane);
              const f32x4 y = p0 + p1; const float ss = wave_sum((y[0] * y[0] + y[1] * y[1]) + (y[2] * y[2] + y[3] * y[3]));
              const float r = 1.0f / sqrtf(ss * (1.0f / 256.0f) + EPS); const f32x4 g = *(const f32x4*)(gmix + 4 * lane);
              u32x2 w; w.x = pk2(y[0] * r * g[0], y[1] * r * g[1]); w.y = pk2(y[2] * r * g[2], y[3] * r * g[3]);
              *(u32x2*)(Y + (size_t)m * DM + 4 * lane) = w; }
            { const u32x4 ow = *(const u32x4*)(OB + (size_t)m * OP + 8 * lane); float v[8];
#pragma unroll
              for (int e = 0; e < 4; ++e) { v[2 * e] = bflo(ow[e]); v[2 * e + 1] = bfhi(ow[e]); }
              float ss = 0.f;
#pragma unroll
              for (int e = 0; e < 8; ++e) ss += v[e] * v[e];
              const float r = 1.0f / sqrtf(wave_sum(ss) * (1.0f / 512.0f) + EPS);
              const f32x4 g0 = *(const f32x4*)(gmix + 512 + 8 * lane), g1 = *(const f32x4*)(gmix + 512 + 8 * lane + 4);
              u32x4 w; w.x = pk2(v[0] * r * g0[0], v[1] * r * g0[1]); w.y = pk2(v[2] * r * g0[2], v[3] * r * g0[3]); w.z = pk2(v[4] * r * g1[0], v[5] * r * g1[1]); w.w = pk2(v[6] * r * g1[2], v[7] * r * g1[3]);
              *(u32x4*)(Y + (size_t)m * DM + 512 + 8 * lane) = w; }
        } }
        grid.sync();
        {
            pg8::Gemm g{Y, (const bf16_t*)(wl + WL_OUT), DM, DM, DM}; pg8::StaticOrder S; S.init(MTOK, DM, G, bx);
            pg8::EpiBf16<0> E{MB, DM};
            pg8::gemm_phase<pg8::EpiBf16<0>, pg8::StaticOrder, true>(lds, g, S, E);
        }
        grid.sync();
        { int lane_ = lane; asm volatile("" : "+v"(lane_));
        for (int m = gw; m < MTOK; m += NGW)
            resnorm_row(MB + (size_t)m * DM, (l == 0 ? x_in : out) + (size_t)m * DM, out + (size_t)m * DM, args.in[I_GPOSTM] + l * DM, args.in[I_GPREF] + l * DM, XN + (size_t)m * DM, lane_); }
        grid.sync();
        {
            pg8::Gemm g{XN, (const bf16_t*)(wl + WL_GU), DM, DM, DM}; pg8::StaticOrder S; S.init(MTOK, 2 * DFF, G, bx);
            pg8::EpiSwiglu E{HB, DFF};
            pg8::gemm_phase<pg8::EpiSwiglu, pg8::StaticOrder, true>(lds, g, S, E);
        }
        grid.sync();
        {
            pg8::Gemm g{HB, (const bf16_t*)(wl + WL_DN), DFF, DFF, DFF}; pg8::StaticOrder S; S.init(MTOK, DM, G, bx);
            pg8::EpiBf16<0> E{MB, DM};
            pg8::gemm_phase<pg8::EpiBf16<0>, pg8::StaticOrder, true>(lds, g, S, E);
        }
        grid.sync();
        {
            const bool more = (l + 1 < DEPTH);
            int lane_ = lane; asm volatile("" : "+v"(lane_));
            for (int m = gw; m < MTOK; m += NGW)
                resnorm_row(MB + (size_t)m * DM, out + (size_t)m * DM, out + (size_t)m * DM, args.in[I_GPOSTF] + l * DM, more ? args.in[I_GPRE] + (l + 1) * DM : nullptr, more ? XN + (size_t)m * DM : nullptr, lane_);
            if (more) grid.sync();
        }
    }
}

extern "C" void kernel_launch(void* const* d_in, const int* in_sizes, int n_in, void* d_out, int out_size, void* d_ws, size_t ws_size, hipStream_t stream) {
    static int grid = 0;
    if (grid == 0) {
        if (n_in != 16 || in_sizes[0] != MTOK * DM || out_size != MTOK * DM || ws_size < WS_END) { fprintf(stderr, "kernel_launch: unexpected shapes (n_in %d, in0 %d, out %d, ws %zu)\n", n_in, n_in > 0 ? in_sizes[0] : -1, out_size, ws_size); grid = -1; return; }
        int dev = 0, cus = 0, per_cu = 0;
        hipGetDevice(&dev); hipDeviceGetAttribute(&cus, hipDeviceAttributeMultiprocessorCount, dev);
        hipFuncSetAttribute((const void*)hybrid_fwd, hipFuncAttributeMaxDynamicSharedMemorySize, LDS_BYTES);
        hipOccupancyMaxActiveBlocksPerMultiprocessor(&per_cu, (const void*)hybrid_fwd, NTHR, LDS_BYTES);
        if (per_cu < 1) { fprintf(stderr, "kernel_launch: occupancy query reports %d blocks per CU\n", per_cu); per_cu = 1; }
        (void)hipGetLastError();
        grid = cus * (per_cu > 1 ? 1 : per_cu);
    }
    if (grid < 0) return;
    Args a{};
    for (int i = 0; i < 16; ++i) a.in[i] = (const float*)d_in[i];
    a.out = (float*)d_out; a.ws = (unsigned char*)d_ws;
    void* kargs[] = {&a};
    hipError_t e = hipLaunchCooperativeKernel((const void*)hybrid_fwd, dim3(grid), dim3(NTHR), kargs, LDS_BYTES, stream);
    if (e != hipSuccess) fprintf(stderr, "cooperative launch failed: %s (grid %d)\n", hipGetErrorString(e), grid);
}
```

```cpp
#include <hip/hip_runtime.h>
#include <hip/hip_cooperative_groups.h>
#include <hip/hip_bf16.h>
#include <cstdio>
#include <cstdint>
#include <cmath>
namespace cg = cooperative_groups;

#define LAS __attribute__((address_space(3)))
#define GAS __attribute__((address_space(1)))
typedef unsigned short bf16_t;
typedef short bf16x8 __attribute__((ext_vector_type(8)));
typedef float f32x4 __attribute__((ext_vector_type(4)));
typedef float f32x2 __attribute__((ext_vector_type(2)));
typedef unsigned u32x4 __attribute__((ext_vector_type(4)));
typedef unsigned u32x2 __attribute__((ext_vector_type(2)));

constexpr int NB = 8, SEQ = 4096, DM = 1024, MTOK = NB * SEQ, DIN = 1536, DFF = 2816, DEPTH = 2;
constexpr int ZP = 1280;
constexpr int ZC_U = 0, ZC_V = 256, ZC_Q = 512, ZC_K = 1024, ZC_VA = 1152;
constexpr int OP = 512;
constexpr float EPS = 1e-6f;
constexpr int NWAVES = 8, NTHR = 512;

constexpr size_t MiB = 1u << 20;
constexpr size_t WS_CTL = 0;
constexpr size_t WS_W = 1 * MiB;
constexpr size_t WL_IN = 0, WL_F = (size_t)1280 * 1024 * 2, WL_OUT = WL_F + (size_t)512 * 1024 * 2, WL_GU = WL_OUT + (size_t)1024 * 1024 * 2,
                 WL_DN = WL_GU + (size_t)5632 * 1024 * 2, WL_SIZE = WL_DN + (size_t)1024 * 2816 * 2;
static_assert(WL_SIZE == 22 * MiB, "weights per layer");
constexpr size_t WS_DFT = 48 * MiB;
constexpr size_t WS_XN = 112 * MiB;
constexpr size_t WS_MB = 176 * MiB;
constexpr size_t WS_H = 240 * MiB;
constexpr size_t WS_Z = 240 * MiB, WS_ZF = 320 * MiB, WS_O = 352 * MiB, WS_Y = 384 * MiB, WS_END = 448 * MiB;

__device__ __forceinline__ unsigned f2bf(float f) { unsigned u = __builtin_bit_cast(unsigned, f); return (u + 0x7fffu + ((u >> 16) & 1u)) >> 16; }
__device__ __forceinline__ unsigned pk2(float lo, float hi) { return f2bf(lo) | (f2bf(hi) << 16); }
__device__ __forceinline__ float bflo(unsigned w) { return __builtin_bit_cast(float, w << 16); }
__device__ __forceinline__ float bfhi(unsigned w) { return __builtin_bit_cast(float, w & 0xffff0000u); }
__device__ __forceinline__ float wave_sum(float v) {
#pragma unroll
    for (int o = 1; o < 64; o <<= 1) v += __shfl_xor(v, o);
    return v;
}
__device__ __forceinline__ float gelu_tanh(float x) {
    const float t = 1.5957691216057308f * (x + 0.044715f * x * x * x);
    const float e = __builtin_amdgcn_exp2f(-t * 1.4426950408889634f);
    return x * __builtin_amdgcn_rcpf(1.f + e);
}
__device__ __forceinline__ float silu_f(float x) {
    const float e = __builtin_amdgcn_exp2f(-x * 1.4426950408889634f);
    return x * __builtin_amdgcn_rcpf(1.f + e);
}

namespace pg8 {
constexpr int BM = 256, BK = 64, HALF = 128, HTB = HALF * BK * 2, STAGE_BYTES = 8 * HTB, NXCD = 8, WGM = 8;
__host__ __device__ __forceinline__ int lds_byte(int r, int c) { const int st = (r >> 4) * 2 + (c >> 5), rr = r & 15, cc = c & 31, ob = rr * 64 + cc * 2; return st * 1024 + (ob ^ (((ob >> 9) & 1) << 5)); }
__host__ __device__ __forceinline__ void stage_rc(int b, int& R, int& C) { const int st = b / 1024, sb = b % 1024, swz = sb ^ (((sb >> 9) & 1) << 5); R = (st >> 1) * 16 + swz / 64; C = (st & 1) * 32 + (swz % 64) / 2; }
__host__ __device__ __forceinline__ int perm32(int rho) { const int n = rho >> 4, i = rho & 15; return 8 * (i >> 2) + 4 * n + (i & 3); }

struct Unit { int pm, pn; };
struct Gemm { const bf16_t* A; const bf16_t* Bt; int lda, ldb, K; };

struct StaticOrder {
    int nM, nN, nwg, G, c;
    __device__ void init(int M, int N, int G_, int c_) { nM = M / BM; nN = N / BM; nwg = nM * nN; G = G_; c = c_; }
    __device__ bool next(int i, Unit& u) const {
        const long L = (long)i * G + c; if (L >= nwg) return false;
        int wgid = (int)L; { const int q = nwg / NXCD, r = nwg % NXCD, xcd = wgid % NXCD, off = wgid / NXCD; wgid = (xcd < r ? xcd * (q + 1) : r * (q + 1) + (xcd - r) * q) + off; }
        const int nig = WGM * nN, gid = wgid / nig, fm = gid * WGM, gsz = (nM - fm) < WGM ? (nM - fm) : WGM;
        u.pm = fm + ((wgid % nig) % gsz); u.pn = (wgid % nig) / gsz; return true;
    }
};
struct OneUnit {
    int pm, pn, have;
    __device__ bool next(int i, Unit& u) const { if (i != 0 || !have) return false; u.pm = pm; u.pn = pn; return true; }
};

__device__ __forceinline__ unsigned cvt_pk_bf16(float lo, float hi) { unsigned r; asm volatile("v_cvt_pk_bf16_f32 %0, %1, %2" : "=v"(r) : "v"(lo), "v"(hi)); return r; }

template <int ACT  > struct EpiBf16 {
    static constexpr bool PERM = true;
    bf16_t* O; int ldc;
    __device__ __forceinline__ void operator()(const f32x4 (&acc)[2][2][4][2], const Unit& u, int wr, int wc, int fr, int fq) const {
        const int row0 = u.pm * BM + wr * 64 + fr; const int col0 = u.pn * BM + wc * 32 + 8 * fq;
        const bool act = (ACT == 1) && (u.pn < 2);
#pragma unroll
        for (int ai = 0; ai < 2; ++ai)
#pragma unroll
            for (int m = 0; m < 4; ++m) { bf16_t* rowp = O + (size_t)(row0 + ai * HALF + m * 16) * ldc + col0;
#pragma unroll
                for (int bj = 0; bj < 2; ++bj) { f32x4 v0 = acc[ai][bj][m][0], v1 = acc[ai][bj][m][1];
                    if (act) {
#pragma unroll
                        for (int e = 0; e < 4; ++e) { v0[e] = gelu_tanh(v0[e]); v1[e] = gelu_tanh(v1[e]); } }
                    u32x4 w; w.x = cvt_pk_bf16(v0[0], v0[1]); w.y = cvt_pk_bf16(v0[2], v0[3]); w.z = cvt_pk_bf16(v1[0], v1[1]); w.w = cvt_pk_bf16(v1[2], v1[3]);
                    *(u32x4*)(rowp + bj * HALF) = w; } }
    }
};
struct EpiSwiglu {
    static constexpr bool PERM = true;
    bf16_t* O; int ldc;
    __device__ __forceinline__ void operator()(const f32x4 (&acc)[2][2][4][2], const Unit& u, int wr, int wc, int fr, int fq) const {
        const int row0 = u.pm * BM + wr * 64 + fr; const int col0 = u.pn * HALF + wc * 32 + 8 * fq;
#pragma unroll
        for (int ai = 0; ai < 2; ++ai)
#pragma unroll
            for (int m = 0; m < 4; ++m) { bf16_t* rowp = O + (size_t)(row0 + ai * HALF + m * 16) * ldc + col0;
                f32x4 v0, v1;
#pragma unroll
                for (int e = 0; e < 4; ++e) { v0[e] = silu_f(acc[ai][0][m][0][e]) * acc[ai][1][m][0][e]; v1[e] = silu_f(acc[ai][0][m][1][e]) * acc[ai][1][m][1][e]; }
                u32x4 w; w.x = cvt_pk_bf16(v0[0], v0[1]); w.y = cvt_pk_bf16(v0[2], v0[3]); w.z = cvt_pk_bf16(v1[0], v1[1]); w.w = cvt_pk_bf16(v1[2], v1[3]);
                *(u32x4*)rowp = w; }
    }
};
struct EpiF32 {
    static constexpr bool PERM = false;
    float* O; int ldc; float scale;
    __device__ __forceinline__ void operator()(const f32x4 (&acc)[2][2][4][2], const Unit& u, int wr, int wc, int fr, int fq) const {
        const int row0 = u.pm * BM + wr * 64 + fr; const int col0 = u.pn * BM + wc * 32 + 4 * fq;
#pragma unroll
        for (int ai = 0; ai < 2; ++ai)
#pragma unroll
            for (int m = 0; m < 4; ++m) { float* rowp = O + (size_t)(row0 + ai * HALF + m * 16) * ldc + col0;
#pragma unroll
                for (int bj = 0; bj < 2; ++bj)
#pragma unroll
                    for (int n = 0; n < 2; ++n) *(f32x4*)(rowp + bj * HALF + n * 16) = acc[ai][bj][m][n] * scale; }
    }
};

template <class Epi, class Sched, bool ALIGN_EPI>
__device__ __forceinline__ void gemm_phase(LAS unsigned char* lds, const Gemm g, const Sched& S, const Epi& E) {
    int tid_l = threadIdx.x; asm volatile("" : "+v"(tid_l));
    const int tid = tid_l, wid = __builtin_amdgcn_readfirstlane(tid >> 6), lane = tid & 63, wr = wid >> 2, wc = wid & 3, fr = lane & 15, fq = lane >> 4;
    const int K = g.K, nt = K / BK;
    unsigned voffA[2], voffB[2];
#pragma unroll
    for (int i = 0; i < 2; ++i) { int R, C; stage_rc(tid * 16 + i * 8192, R, C); const int Rb = Epi::PERM ? ((R & ~31) + perm32(R & 31)) : R;
        voffA[i] = (unsigned)(R * g.lda + C) * 2u; voffB[i] = (unsigned)(Rb * g.ldb + C) * 2u; }
    const size_t kstep = (size_t)(BK * 2);
    const size_t hstepA = (size_t)HALF * g.lda * 2, hstepB = (size_t)HALF * g.ldb * 2;
    const size_t tstepA = 2 * hstepA, tstepB = 2 * hstepB;
    const unsigned ldsw = (unsigned)wid * 1024u;
    const int aoff = lds_byte(wr * 64 + fr, fq * 8), boff = lds_byte(wc * 32 + fr, fq * 8);
#define PG8_SA(b, h) (((b) * 2 + (h)) * HTB)
#define PG8_SB(b, h) ((4 + (b) * 2 + (h)) * HTB)
#define PG8_STAGE(bufoff, gbase, voff) do { _Pragma("unroll") for (int _i = 0; _i < 2; ++_i) \
        __builtin_amdgcn_global_load_lds((const unsigned*)((const char*)(gbase) + (voff)[_i]), (LAS unsigned*)(lds + (bufoff) + ldsw + _i * 8192), 16, 0, 0); } while (0)
#define PG8_LDA(dst, b, h) do { _Pragma("unroll") for (int m = 0; m < 4; ++m) _Pragma("unroll") for (int k = 0; k < 2; ++k) dst[m][k] = *(const LAS bf16x8*)(lds + PG8_SA(b, h) + aoff + m * 2048 + k * 1024); } while (0)
#define PG8_LDB(dst, b, h) do { _Pragma("unroll") for (int n = 0; n < 2; ++n) _Pragma("unroll") for (int k = 0; k < 2; ++k) dst[n][k] = *(const LAS bf16x8*)(lds + PG8_SB(b, h) + boff + n * 2048 + k * 1024); } while (0)
#define PG8_MMA(ai, bj, At, Bt) do { __builtin_amdgcn_s_setprio(1); _Pragma("unroll") for (int m = 0; m < 4; ++m) _Pragma("unroll") for (int n = 0; n < 2; ++n) _Pragma("unroll") for (int k = 0; k < 2; ++k) \
        acc[ai][bj][m][n] = __builtin_amdgcn_mfma_f32_16x16x32_bf16(Bt[n][k], At[m][k], acc[ai][bj][m][n], 0, 0, 0); __builtin_amdgcn_s_setprio(0); } while (0)
#define PG8_WAIT_V(n) asm volatile("s_waitcnt vmcnt(" #n ")" ::: "memory")
#define PG8_WAIT_L(n) asm volatile("s_waitcnt lgkmcnt(" #n ")" ::: "memory")
#define PG8_BAR __builtin_amdgcn_s_barrier()
#define PG8_SCHED __builtin_amdgcn_sched_barrier(0)
    Unit cur, nxt; int ui = 0;
    if (!S.next(0, cur)) return;
    f32x4 acc[2][2][4][2];
#pragma unroll
    for (int a = 0; a < 2; ++a)
#pragma unroll
        for (int b = 0; b < 2; ++b)
#pragma unroll
            for (int m = 0; m < 4; ++m)
#pragma unroll
                for (int n = 0; n < 2; ++n) acc[a][b][m][n] = (f32x4){0.f, 0.f, 0.f, 0.f};
    bf16x8 At[4][2], B0[2][2], B1[2][2];
    const char* cA = (const char*)g.A + (size_t)cur.pm * tstepA; const char* cB = (const char*)g.Bt + (size_t)cur.pn * tstepB;
    PG8_STAGE(PG8_SB(0, 0), cB, voffB); PG8_STAGE(PG8_SB(0, 1), cB + hstepB, voffB); PG8_STAGE(PG8_SA(0, 0), cA, voffA); PG8_STAGE(PG8_SA(0, 1), cA + hstepA, voffA);
    if (wr == 1) PG8_BAR;
    PG8_WAIT_V(2); PG8_BAR;
    PG8_STAGE(PG8_SB(1, 0), cB + kstep, voffB); PG8_STAGE(PG8_SA(1, 0), cA + kstep, voffA); PG8_STAGE(PG8_SB(1, 1), cB + hstepB + kstep, voffB);
    PG8_WAIT_V(6); PG8_BAR;
    for (;;) {
        const bool has_next = S.next(ui + 1, nxt);
        const char* nA = has_next ? (const char*)g.A + (size_t)nxt.pm * tstepA : cA; const char* nB = has_next ? (const char*)g.Bt + (size_t)nxt.pn * tstepB : cB;
        for (int t = 0; t < nt; t += 2) {
            const bool last = (t == nt - 2);
            const char* a1 = cA + (size_t)(t + 1) * kstep;
            const char* a2 = last ? nA : cA + (size_t)(t + 2) * kstep; const char* b2 = last ? nB : cB + (size_t)(t + 2) * kstep;
            const char* a3 = a2 + kstep; const char* b3 = b2 + kstep;
            PG8_LDB(B0, 0, 0); PG8_LDB(B1, 0, 1); PG8_SCHED; PG8_LDA(At, 0, 0); PG8_STAGE(PG8_SA(1, 1), a1 + hstepA, voffA);
            PG8_WAIT_V(8); PG8_WAIT_L(0); PG8_BAR; PG8_MMA(0, 0, At, B0); PG8_MMA(0, 1, At, B1); PG8_BAR; PG8_SCHED;
            PG8_LDA(At, 0, 1); PG8_STAGE(PG8_SB(0, 0), b2, voffB); PG8_STAGE(PG8_SB(0, 1), b2 + hstepB, voffB); PG8_STAGE(PG8_SA(0, 0), a2, voffA);
            PG8_WAIT_V(8); PG8_WAIT_L(0); PG8_BAR; PG8_MMA(1, 0, At, B0); PG8_MMA(1, 1, At, B1); PG8_BAR; PG8_SCHED;
            PG8_LDB(B0, 1, 0); PG8_LDB(B1, 1, 1); PG8_SCHED; PG8_LDA(At, 1, 0); PG8_STAGE(PG8_SA(0, 1), a2 + hstepA, voffA);
            PG8_WAIT_V(8); PG8_WAIT_L(0); PG8_BAR; PG8_MMA(0, 0, At, B0); PG8_MMA(0, 1, At, B1); PG8_BAR; PG8_SCHED;
            PG8_LDA(At, 1, 1); PG8_STAGE(PG8_SB(1, 0), b3, voffB); PG8_STAGE(PG8_SB(1, 1), b3 + hstepB, voffB); PG8_STAGE(PG8_SA(1, 0), a3, voffA);
            PG8_WAIT_V(8); PG8_WAIT_L(0); PG8_BAR; PG8_MMA(1, 0, At, B0); PG8_MMA(1, 1, At, B1); PG8_BAR; PG8_SCHED;
        }
        if constexpr (ALIGN_EPI) { if (wr == 0) PG8_BAR; }
        E(acc, cur, wr, wc, fr, fq);
        if (!has_next) break;
#pragma unroll
        for (int a = 0; a < 2; ++a)
#pragma unroll
            for (int b = 0; b < 2; ++b)
#pragma unroll
                for (int m = 0; m < 4; ++m)
#pragma unroll
                    for (int n = 0; n < 2; ++n) acc[a][b][m][n] = (f32x4){0.f, 0.f, 0.f, 0.f};
        cur = nxt; cA = nA; cB = nB; ++ui;
        if constexpr (ALIGN_EPI) { if (wr == 1) PG8_BAR; }
    }
    PG8_WAIT_V(0);
    if constexpr (!ALIGN_EPI) { if (wr == 0) PG8_BAR; }
    PG8_BAR;
#undef PG8_SA
#undef PG8_SB
#undef PG8_STAGE
#undef PG8_LDA
#undef PG8_LDB
#undef PG8_MMA
#undef PG8_WAIT_V
#undef PG8_WAIT_L
#undef PG8_BAR
#undef PG8_SCHED
}
}

namespace attn_body {
using bf16 = __hip_bfloat16;
using s16x4 = __attribute__((ext_vector_type(4))) short;
using f32x16 = __attribute__((ext_vector_type(16))) float;
constexpr int NW = 8, QBLK = 32, QB = QBLK * NW, KVBLK = 64;
__device__ __forceinline__ int crow(int r, int hi) { return (r & 3) + 8 * (r >> 2) + 4 * hi; }
#define SBAR() __builtin_amdgcn_sched_barrier(0)
constexpr int NSLOT = 3, SLOTB = 8192;
constexpr int LDS_K = 0, LDS_V = NSLOT * SLOTB, LDS_WS = 2 * NSLOT * SLOTB, LDS_OST = LDS_WS + NW * 64 * 4, LDS_BYTES = LDS_OST + NW * 4096;
constexpr float C2 = 0.125f * 1.4426950408889634f;
__device__ __forceinline__ void glds16(const void* gsrc, unsigned lds_dst) { unsigned keep;
  asm volatile("s_mov_b32 %0, m0\n\ts_mov_b32 m0, %2\n\ts_nop 0\n\tglobal_load_lds_dwordx4 %1, off\n\ts_mov_b32 m0, %0" : "=&s"(keep) : "v"(gsrc), "s"(lds_dst) : "memory"); }
__device__ __forceinline__ float max3f(float a, float b, float c) { float r; asm("v_max3_f32 %0, %1, %2, %3" : "=v"(r) : "v"(a), "v"(b), "v"(c)); return r; }
__device__ __forceinline__ float max2f(float a, float b) { float r; asm("v_max_f32_e32 %0, %1, %2" : "=v"(r) : "v"(a), "v"(b)); return r; }
__device__ __forceinline__ float fadd_s(float a, float b) { float r; asm("v_add_f32_e32 %0, %1, %2" : "=v"(r) : "v"(a), "v"(b)); return r; }
__device__ __forceinline__ float fsub_s(float a, float b) { float r; asm("v_sub_f32_e32 %0, %1, %2" : "=v"(r) : "v"(a), "v"(b)); return r; }
typedef float f32x2_t __attribute__((ext_vector_type(2))); typedef __bf16 bf16x2_t __attribute__((ext_vector_type(2)));
__device__ __forceinline__ unsigned cvtpk_s(float lo, float hi) { f32x2_t v = {lo, hi}; bf16x2_t b = __builtin_convertvector(v, bf16x2_t); return __builtin_bit_cast(unsigned, b); }
#define WAIT_BAR(N) asm volatile("s_waitcnt vmcnt(" #N ") lgkmcnt(0)\n\ts_barrier" ::: "memory")

__device__ __forceinline__ void qkt(f32x16& p0, f32x16& p1, const char* Kslot, const bf16x8* qr, const f32x16& negm, int r32, int hi) {
  const char* kb = Kslot + hi * 1024 + r32 * 16;
  #pragma unroll
  for (int d0 = 0; d0 < 4; ++d0) {
    const bf16x8 b0 = *reinterpret_cast<const bf16x8*>(kb + d0 * 2048);
    const bf16x8 b1 = *reinterpret_cast<const bf16x8*>(kb + d0 * 2048 + 512);
    if (d0 == 0) { p0 = __builtin_amdgcn_mfma_f32_32x32x16_bf16(b0, qr[0], negm, 0, 0, 0); p1 = __builtin_amdgcn_mfma_f32_32x32x16_bf16(b1, qr[0], negm, 0, 0, 0); }
    else { p0 = __builtin_amdgcn_mfma_f32_32x32x16_bf16(b0, qr[d0], p0, 0, 0, 0); p1 = __builtin_amdgcn_mfma_f32_32x32x16_bf16(b1, qr[d0], p1, 0, 0, 0); } }
}
typedef __attribute__((address_space(3))) const char* lds_cptr;
typedef short v4i16_t __attribute__((ext_vector_type(4)));
__device__ __forceinline__ void kload8(bf16x8* kf, lds_cptr kp) {
  kf[0] = *(const __attribute__((address_space(3))) bf16x8*)(kp);        kf[1] = *(const __attribute__((address_space(3))) bf16x8*)(kp + 512);
  kf[2] = *(const __attribute__((address_space(3))) bf16x8*)(kp + 2048); kf[3] = *(const __attribute__((address_space(3))) bf16x8*)(kp + 2560);
  kf[4] = *(const __attribute__((address_space(3))) bf16x8*)(kp + 4096); kf[5] = *(const __attribute__((address_space(3))) bf16x8*)(kp + 4608);
  kf[6] = *(const __attribute__((address_space(3))) bf16x8*)(kp + 6144); kf[7] = *(const __attribute__((address_space(3))) bf16x8*)(kp + 6656);
}
__device__ __forceinline__ void kload2(bf16x8* kf, lds_cptr kp, int j) { kf[2 * j] = *(const __attribute__((address_space(3))) bf16x8*)(kp + j * 2048); kf[2 * j + 1] = *(const __attribute__((address_space(3))) bf16x8*)(kp + j * 2048 + 512); }
__device__ __forceinline__ s16x4 vtr(lds_cptr p) { return __builtin_bit_cast(s16x4, __builtin_amdgcn_ds_read_tr16_b64_v4i16((__attribute__((address_space(3))) v4i16_t*)p)); }
__device__ __forceinline__ float rowmax(const f32x16& p0, const f32x16& p1) {
  float a = max3f(p0[0], p0[1], p1[0]), b = max3f(p0[2], p0[3], p1[1]); a = max3f(a, p1[2], p1[3]);
  #pragma unroll
  for (int r = 4; r < 16; r += 4) { a = max3f(a, p0[r], p0[r + 1]); b = max3f(b, p0[r + 2], p0[r + 3]); a = max3f(a, p1[r], p1[r + 1]); b = max3f(b, p1[r + 2], p1[r + 3]); }
  const float m = max2f(a, b);
  auto rr = __builtin_amdgcn_permlane32_swap(__float_as_uint(m), __float_as_uint(m), false, false);
  return max2f(__uint_as_float(rr[0]), __uint_as_float(rr[1]));
}
__device__ __forceinline__ void pv(f32x16* o, int vb, bf16x8 pa0, bf16x8 pa1, bf16x8 pa2, bf16x8 pa3) {
  #pragma unroll
  for (int d0 = 0; d0 < 2; ++d0) { s16x4 lo[4], hi[4];
    #pragma unroll
    for (int ks = 0; ks < 4; ++ks) {
      asm volatile("ds_read_b64_tr_b16 %0,%1 offset:%c2" : "=&v"(lo[ks]) : "v"(vb), "i"(d0 * 4096 + ks * 1024) : "memory");
      asm volatile("ds_read_b64_tr_b16 %0,%1 offset:%c2" : "=&v"(hi[ks]) : "v"(vb), "i"(d0 * 4096 + ks * 1024 + 512) : "memory"); }
    asm volatile("s_waitcnt lgkmcnt(0)" ::: "memory"); SBAR();
    #define PK(k) (bf16x8){lo[k][0], lo[k][1], lo[k][2], lo[k][3], hi[k][0], hi[k][1], hi[k][2], hi[k][3]}
    o[d0] = __builtin_amdgcn_mfma_f32_32x32x16_bf16(pa0, PK(0), o[d0], 0, 0, 0);
    o[d0] = __builtin_amdgcn_mfma_f32_32x32x16_bf16(pa1, PK(1), o[d0], 0, 0, 0);
    o[d0] = __builtin_amdgcn_mfma_f32_32x32x16_bf16(pa2, PK(2), o[d0], 0, 0, 0);
    o[d0] = __builtin_amdgcn_mfma_f32_32x32x16_bf16(pa3, PK(3), o[d0], 0, 0, 0);
    #undef PK
  }
}

template <int THRL> __device__ __forceinline__ void attn_unit(int b, int h, int qb, const bf16* Z, bf16* O, const float* gq, const float* ropec, const float* ropes, char* shm) {
  int tid_l = threadIdx.x; asm volatile("" : "+v"(tid_l));
  const int tid = tid_l, lane = tid & 63, r32 = lane & 31, hi = lane >> 5; const int wid = __builtin_amdgcn_readfirstlane(tid >> 6);
  const long rowbase = (long)b * SEQ; const int q0 = qb * QB; const int kvh = h >> 2;
  const bf16* Qw = Z + (rowbase + q0 + wid * QBLK) * ZP + ZC_Q + h * 64;
  const bf16* Kh = Z + rowbase * ZP + ZC_K + kvh * 64, *Vh = Z + rowbase * ZP + ZC_VA + kvh * 64;
  const unsigned lds0 = (unsigned)(uintptr_t)shm;
  float* wsf = (float*)(shm + LDS_WS) + wid * 64;
  const bf16* ksrc = Kh + (long)lane * ZP + wid * 8;
  const bf16* vsrc = Vh + (long)(16 * (wid & 3) + (lane >> 2)) * ZP + (wid >> 2) * 32 + (lane & 3) * 8;
  const unsigned kdst = lds0 + LDS_K + wid * 1024, vdst = lds0 + LDS_V + wid * 1024;
  #define DMA_K(t, slot) glds16(ksrc + (long)(t) * KVBLK * ZP, (unsigned)__builtin_amdgcn_readfirstlane(kdst + (slot)))
  #define DMA_V(t, slot) glds16(vsrc + (long)(t) * KVBLK * ZP, (unsigned)__builtin_amdgcn_readfirstlane(vdst + (slot)))
  const int vb0 = (int)(lds0 + LDS_V) + ((lane >> 4) & 1) * 32 + (lane & 3) * 8 + (4 * hi + ((lane & 15) >> 2)) * 64;
  const char* Kbase = shm + LDS_K; bf16x8 kf[8];
  const lds_cptr shm3 = (lds_cptr)shm; const lds_cptr kp0 = shm3 + LDS_K + hi * 1024 + r32 * 16; const lds_cptr vp0 = shm3 + LDS_V + ((lane >> 4) & 1) * 32 + (lane & 3) * 8 + (4 * hi + ((lane & 15) >> 2)) * 64;
  constexpr int NT = SEQ / KVBLK;
  DMA_K(0, 0); DMA_V(0, 0); DMA_K(1, SLOTB);
  bf16x8 qr[4];
  {
    u32x4 raw[4];
    #pragma unroll
    for (int d0 = 0; d0 < 4; ++d0) raw[d0] = *reinterpret_cast<const u32x4*>(&Qw[(long)r32 * ZP + d0 * 16 + hi * 8]);
    float ss = 0.f;
    #pragma unroll
    for (int d0 = 0; d0 < 4; ++d0)
      #pragma unroll
      for (int e = 0; e < 4; ++e) { const float a = bflo(raw[d0][e]), c = bfhi(raw[d0][e]); ss += a * a + c * c; }
    ss += __shfl_xor(ss, 32);
    const float rinv = 1.0f / sqrtf(ss * (1.0f / 64.0f) + EPS);
    const int pos = q0 + wid * QBLK + r32, prow = pos >> 6, pcol = pos & 63;
    #pragma unroll
    for (int hf = 0; hf < 2; ++hf) {
      const int pp = hf ? pcol : prow;
      u32x4 w1, w2;
      #pragma unroll
      for (int e2 = 0; e2 < 4; ++e2) {
        float o1[2], o2[2];
        #pragma unroll
        for (int s = 0; s < 2; ++s) { const int e = 2 * e2 + s; const int i = 8 * hi + e;
          const float cs = ropec[pp * 16 + i], sn = ropes[pp * 16 + i];
          const unsigned wa = raw[2 * hf][e2], wb = raw[2 * hf + 1][e2];
          const float x1 = (s ? bfhi(wa) : bflo(wa)) * rinv * gq[32 * hf + i], x2 = (s ? bfhi(wb) : bflo(wb)) * rinv * gq[32 * hf + 16 + i];
          o1[s] = (x1 * cs - x2 * sn) * C2; o2[s] = (x2 * cs + x1 * sn) * C2; }
        w1[e2] = cvtpk_s(o1[0], o1[1]); w2[e2] = cvtpk_s(o2[0], o2[1]); }
      qr[2 * hf] = __builtin_bit_cast(bf16x8, w1); qr[2 * hf + 1] = __builtin_bit_cast(bf16x8, w2);
    }
  }
  float mhat = 0.f, l_reg = 0.f; f32x16 o[2]; o[0] = f32x16{}; o[1] = f32x16{}; f32x16 negm = f32x16{}; asm volatile("" : "+v"(negm));
  bool resc = false;
  #define START(P0, P1) do { const float rm = rowmax(P0, P1); resc = false; \
    { const float dl = rm; mhat = fadd_s(mhat, dl); \
      _Pragma("unroll") for (int r = 0; r < 16; ++r) { P0[r] = fsub_s(P0[r], dl); P1[r] = fsub_s(P1[r], dl); } \
      _Pragma("unroll") for (int r = 0; r < 16; ++r) negm[r] = -mhat; asm volatile("" : "+v"(negm)); } \
    _Pragma("unroll") for (int r = 0; r < 16; ++r) P0[r] = __builtin_amdgcn_exp2f(P0[r]); } while (0)
  #define RESC() do { if (resc) { asm volatile("s_waitcnt lgkmcnt(0)" ::: "memory"); \
      _Pragma("unroll") for (int d_ = 0; d_ < 2; ++d_) _Pragma("unroll") for (int r = 0; r < 16; ++r) o[d_][r] *= wsf[crow(r, hi)]; } } while (0)
  f32x16 pA0, pA1, pB0, pB1;
  int sl_prev = 0, sl_cur = 0, sl_next = SLOTB;
  #define ROT() do { sl_prev = sl_cur; sl_cur = sl_next; sl_next = (sl_next == (NSLOT - 1) * SLOTB) ? 0 : sl_next + SLOTB; } while (0)
  DMA_K(2, 2 * SLOTB);
  WAIT_BAR(3);
  qkt(pA0, pA1, Kbase, qr, negm, r32, hi); asm volatile("s_nop 15\n\ts_nop 7" : "+v"(pA0), "+v"(pA1));
  START(pA0, pA1);
  _Pragma("unroll") for (int r = 0; r < 16; ++r) pA1[r] = __builtin_amdgcn_exp2f(pA1[r]);
  WAIT_BAR(0);
  DMA_K(3, 0); DMA_V(1, SLOTB);
  ROT();
  kload8(kf, kp0 + sl_cur);
  WAIT_BAR(2);
  s16x4 vlo[8], vhi[8]; u32x4 pw0, pw1, pw2, pw3;
  #define PKW(P, B) cvtpk_s(P[B], P[B + 1])
  #define PAF(k) __builtin_bit_cast(bf16x8, pw##k)
  #define VFR(i) (bf16x8){vlo[i][0], vlo[i][1], vlo[i][2], vlo[i][3], vhi[i][0], vhi[i][1], vhi[i][2], vhi[i][3]}
  #define PIN(x) asm volatile("" : "+v"(x))
  #define MX3(a, b, c) __builtin_fmaxf(__builtin_fmaxf((a), (b)), (c))
  #define GAPA(MF, A0, A1, A2, A3, W0, W1, PW) do { MF; sacc += A0; sacc += A1; sacc += A2; sacc += A3; PIN(sacc); W0; W1; PIN(PW); SBAR(); } while (0)
  #define EX(v) __builtin_amdgcn_exp2f(v)
  #define GAPB(MF, X, B) do { MF; X[B] = EX(X[B]); X[B + 1] = EX(X[B + 1]); X[B + 2] = EX(X[B + 2]); X[B + 3] = EX(X[B + 3]); PIN(X); SBAR(); } while (0)
  #define VRD(i) do { vlo[i] = vtr(vp_ + (((i) >> 2) * 4096 + ((i) & 3) * 1024)); vhi[i] = vtr(vp_ + (((i) >> 2) * 4096 + ((i) & 3) * 1024 + 512)); } while (0)
  #define KRD(G, j) do { if (G) { kload2(kf, kp0 + sl_next, j); SBAR(); } } while (0)
  #define STEP(C0, C1, P0, P1, t, GK, GV, GL) do { SBAR(); \
    const lds_cptr vp_ = vp0 + sl_prev; \
    VRD(0); SBAR(); float sacc = (P0[0] + P0[1]); \
    GAPA(C0 = __builtin_amdgcn_mfma_f32_32x32x16_bf16(kf[0], qr[0], negm, 0, 0, 0), P0[2], P0[3], P0[4], P0[5],     pw0[0] = PKW(P0, 0), pw0[1] = PKW(P0, 2), pw0); \
    VRD(4); SBAR(); GAPA(C1 = __builtin_amdgcn_mfma_f32_32x32x16_bf16(kf[1], qr[0], negm, 0, 0, 0), P0[6], P0[7], P0[8], P0[9],     pw0[2] = PKW(P0, 4), pw0[3] = PKW(P0, 6), pw0); \
    VRD(1); SBAR(); GAPA(C0 = __builtin_amdgcn_mfma_f32_32x32x16_bf16(kf[2], qr[1], C0, 0, 0, 0),   P0[10], P0[11], P0[12], P0[13], pw1[0] = PKW(P0, 8), pw1[1] = PKW(P0, 10), pw1); \
    VRD(5); SBAR(); GAPA(C1 = __builtin_amdgcn_mfma_f32_32x32x16_bf16(kf[3], qr[1], C1, 0, 0, 0),   P0[14], P0[15], P1[0], P1[1],   pw1[2] = PKW(P0, 12), pw1[3] = PKW(P0, 14), pw1); \
    VRD(2); SBAR(); GAPA(C0 = __builtin_amdgcn_mfma_f32_32x32x16_bf16(kf[4], qr[2], C0, 0, 0, 0),   P1[2], P1[3], P1[4], P1[5],     pw2[0] = PKW(P1, 0), pw2[1] = PKW(P1, 2), pw2); \
    VRD(6); SBAR(); GAPA(C1 = __builtin_amdgcn_mfma_f32_32x32x16_bf16(kf[5], qr[2], C1, 0, 0, 0),   P1[6], P1[7], P1[8], P1[9],     pw2[2] = PKW(P1, 4), pw2[3] = PKW(P1, 6), pw2); \
    VRD(3); SBAR(); GAPA(C0 = __builtin_amdgcn_mfma_f32_32x32x16_bf16(kf[6], qr[3], C0, 0, 0, 0),   P1[10], P1[11], P1[12], P1[13], pw3[0] = PKW(P1, 8), pw3[1] = PKW(P1, 10), pw3); \
    VRD(7); SBAR(); GAPA(C1 = __builtin_amdgcn_mfma_f32_32x32x16_bf16(kf[7], qr[3], C1, 0, 0, 0),   P1[14], P1[15], 0.f, 0.f,       pw3[2] = PKW(P1, 12), pw3[3] = PKW(P1, 14), pw3); \
    l_reg += sacc; \
    if (GK) { DMA_K((t) + 3, sl_cur); } if (GV) { DMA_V((t) + 1, sl_next); } \
    { float a = MX3(C0[0], C0[1], C1[0]), b = MX3(C0[2], C0[3], C1[1]); a = MX3(a, C1[2], C1[3]); \
      _Pragma("unroll") for (int r = 4; r < 16; r += 4) { a = MX3(a, C0[r], C0[r + 1]); b = MX3(b, C0[r + 2], C0[r + 3]); a = MX3(a, C1[r], C1[r + 1]); b = MX3(b, C1[r + 2], C1[r + 3]); } \
      float rm = __builtin_fmaxf(a, b); { auto rr = __builtin_amdgcn_permlane32_swap(__float_as_uint(rm), __float_as_uint(rm), false, false); rm = __builtin_fmaxf(__uint_as_float(rr[0]), __uint_as_float(rr[1])); } \
      resc = false; \
      if (__builtin_expect(__any(rm > (float)THRL), 0)) { const float dl = __builtin_fmaxf(rm, 0.f); mhat += dl; \
        _Pragma("unroll") for (int r = 0; r < 16; ++r) { C0[r] -= dl; C1[r] -= dl; } \
        _Pragma("unroll") for (int r = 0; r < 16; ++r) negm[r] = -mhat; asm volatile("" : "+v"(negm)); \
        const float f = __builtin_amdgcn_exp2f(-dl); l_reg *= f; if (hi == 0) wsf[r32] = f; resc = true; } } \
    SBAR(); \
    GAPB(o[0] = __builtin_amdgcn_mfma_f32_32x32x16_bf16(PAF(0), VFR(0), o[0], 0, 0, 0), C0, 0); \
    GAPB(o[1] = __builtin_amdgcn_mfma_f32_32x32x16_bf16(PAF(0), VFR(4), o[1], 0, 0, 0), C0, 4); \
    KRD(GL, 0); GAPB(o[0] = __builtin_amdgcn_mfma_f32_32x32x16_bf16(PAF(1), VFR(1), o[0], 0, 0, 0), C0, 8); \
    KRD(GL, 1); GAPB(o[1] = __builtin_amdgcn_mfma_f32_32x32x16_bf16(PAF(1), VFR(5), o[1], 0, 0, 0), C0, 12); \
    KRD(GL, 2); GAPB(o[0] = __builtin_amdgcn_mfma_f32_32x32x16_bf16(PAF(2), VFR(2), o[0], 0, 0, 0), C1, 0); \
    KRD(GL, 3); GAPB(o[1] = __builtin_amdgcn_mfma_f32_32x32x16_bf16(PAF(2), VFR(6), o[1], 0, 0, 0), C1, 4); \
    GAPB(o[0] = __builtin_amdgcn_mfma_f32_32x32x16_bf16(PAF(3), VFR(3), o[0], 0, 0, 0), C1, 8); \
    GAPB(o[1] = __builtin_amdgcn_mfma_f32_32x32x16_bf16(PAF(3), VFR(7), o[1], 0, 0, 0), C1, 12); \
    } while (0)
  int t = 1;
  for (; t + 5 < NT; t += 2) {
    STEP(pB0, pB1, pA0, pA1, t, true, true, true);     WAIT_BAR(2); RESC(); ROT();
    STEP(pA0, pA1, pB0, pB1, t + 1, true, true, true); WAIT_BAR(2); RESC(); ROT();
  }
  #define ENDW(tt) do { if ((tt) + 3 < NT) { WAIT_BAR(2); } else if ((tt) + 2 < NT) { WAIT_BAR(1); } else { WAIT_BAR(0); } } while (0)
  for (; t + 1 < NT; t += 2) {
    STEP(pB0, pB1, pA0, pA1, t, (t + 3 < NT), (t + 1 < NT), (t + 1 < NT));         ENDW(t);     RESC(); ROT();
    STEP(pA0, pA1, pB0, pB1, t + 1, (t + 4 < NT), (t + 2 < NT), (t + 2 < NT));     ENDW(t + 1); RESC(); ROT();
  }
  STEP(pB0, pB1, pA0, pA1, NT - 1, false, false, false); RESC();
  { float sacc = pB0[0] + pB0[1]; _Pragma("unroll") for (int r = 2; r < 16; ++r) sacc += pB0[r]; _Pragma("unroll") for (int r = 0; r < 16; ++r) sacc += pB1[r]; l_reg += sacc;
    pw0 = (u32x4){PKW(pB0, 0), PKW(pB0, 2), PKW(pB0, 4), PKW(pB0, 6)}; pw1 = (u32x4){PKW(pB0, 8), PKW(pB0, 10), PKW(pB0, 12), PKW(pB0, 14)}; pw2 = (u32x4){PKW(pB1, 0), PKW(pB1, 2), PKW(pB1, 4), PKW(pB1, 6)}; pw3 = (u32x4){PKW(pB1, 8), PKW(pB1, 10), PKW(pB1, 12), PKW(pB1, 14)};
    SBAR(); pv(o, vb0 + sl_cur, PAF(0), PAF(1), PAF(2), PAF(3)); }
  #undef PKW
  #undef PAF
  #undef VFR
  #undef PIN
  #undef MX3
  #undef GAPA
  #undef GAPB
  #undef EX
  #undef VRD
  #undef KRD
  #undef STEP
  #undef ENDW
  { auto rr = __builtin_amdgcn_permlane32_swap(__float_as_uint(l_reg), __float_as_uint(l_reg), false, false); l_reg = __uint_as_float(rr[0]) + __uint_as_float(rr[1]); }
  if (hi == 0) wsf[32 + r32] = l_reg; asm volatile("s_waitcnt lgkmcnt(0)" ::: "memory");
  float rli[16];
  #pragma unroll
  for (int r = 0; r < 16; ++r) rli[r] = __builtin_amdgcn_rcpf(wsf[32 + crow(r, hi)]);
  bf16* Ow = O + (rowbase + q0 + wid * QBLK) * OP + h * 64;
  { bf16* stg = (bf16*)(shm + LDS_OST) + wid * 2048;
    #pragma unroll
    for (int r = 0; r < 16; ++r) { const int orow = crow(r, hi);
      #pragma unroll
      for (int d0 = 0; d0 < 2; ++d0) stg[orow * 64 + d0 * 32 + r32] = __float2bfloat16(o[d0][r] * rli[r]); }
    asm volatile("s_waitcnt lgkmcnt(0)" ::: "memory");
    #pragma unroll
    for (int i = 0; i < 4; ++i) { const int row = i * 8 + (lane >> 3), ch = lane & 7; const u32x4 v = *(const u32x4*)(stg + row * 64 + ch * 8); *(u32x4*)(Ow + (long)row * OP + ch * 8) = v; } }
  asm volatile("s_waitcnt lgkmcnt(0)\n\ts_barrier" ::: "memory");
  #undef DMA_K
  #undef DMA_V
  #undef START
  #undef RESC
  #undef ROT
}
#undef SBAR
#undef WAIT_BAR
}


#define XB_TMO      128
#define XB_XCNT(j)  (256  + 64 * (j))
#define XB_XSUB(j)  (1280 + 64 * (j))
#define XB_XGEN(j)  (2304 + 64 * (j))
#define XB_TOP      3328
#define XB_TOPGEN   3392
#define XCD_BAR_WORDS 3456
#define XB_SPIN_CAP (1u << 18)
__device__ __forceinline__ unsigned xb_ld(unsigned* p)              { return __hip_atomic_load(p, __ATOMIC_RELAXED, __HIP_MEMORY_SCOPE_AGENT); }
__device__ __forceinline__ unsigned xb_add(unsigned* p, unsigned v) { return __hip_atomic_fetch_add(p, v, __ATOMIC_RELAXED, __HIP_MEMORY_SCOPE_AGENT); }
__device__ __forceinline__ unsigned xb_xcc_id() { return (unsigned)__builtin_amdgcn_s_getreg((3 << 11) | 20) & 0xFu; }
#define XB_SPIN(cond, bar) do { unsigned _sp = 0; while (cond) { __builtin_amdgcn_s_sleep(1); \
    if ((++_sp & 255u) == 0u) { if (xb_ld(&(bar)[XB_TMO])) break; if (_sp > XB_SPIN_CAP) { atomicAdd(&(bar)[XB_TMO], 1u); break; } } } } while (0)
struct XcdBarrier { unsigned* bar; unsigned x; volatile LAS unsigned* st; };
__device__ __forceinline__ XcdBarrier xcd_barrier_post(unsigned* bar, volatile LAS unsigned* st) {
    XcdBarrier b; b.bar = bar; b.x = xb_xcc_id(); b.st = st;
    if (threadIdx.x == 0) (void)xb_add(&bar[XB_XCNT(b.x)], 1u);
    return b;
}
__device__ __forceinline__ void xcd_barrier_complete(unsigned* bar, unsigned x, unsigned& nloc, unsigned& nx) {
    const unsigned G = gridDim.x * gridDim.y * gridDim.z;
    unsigned sum, cnt, mine, sp = 0u;
    for (;;) {
        sum = 0u; cnt = 0u; mine = 0u;
#pragma unroll
        for (unsigned j = 0; j < 16; ++j) { const unsigned c = xb_ld(&bar[XB_XCNT(j)]); sum += c; cnt += (c > 0u) ? 1u : 0u; mine = (j == x) ? c : mine; }
        if (sum == G) break;
        __builtin_amdgcn_s_sleep(1);
        if ((++sp & 255u) == 0u) { if (xb_ld(&bar[XB_TMO])) break; if (sp > XB_SPIN_CAP) { atomicAdd(&bar[XB_TMO], 1u); break; } }
    }
    nloc = mine > 0u ? mine : 1u; nx = cnt > 0u ? cnt : 1u;
}
__device__ __forceinline__ void xcd_barrier(const XcdBarrier& b) {
    asm volatile("s_waitcnt vmcnt(0)" ::: "memory");
    __syncthreads();
    if (threadIdx.x == 0) {
        unsigned* bar = b.bar;
        __builtin_amdgcn_s_waitcnt(0);
        unsigned nloc = b.st[0], nx = b.st[1];
        if (nloc == 0u) { xcd_barrier_complete(bar, b.x, nloc, nx); b.st[0] = nloc; b.st[1] = nx; }
        const unsigned old = xb_add(&bar[XB_XSUB(b.x)], 1u);
        const unsigned gen = old / nloc;
        if (old + 1u == (gen + 1u) * nloc) {
            __builtin_amdgcn_fence(__ATOMIC_RELEASE, "agent");
            asm volatile("s_waitcnt vmcnt(0)" ::: "memory");
            const unsigned og = xb_add(&bar[XB_TOP], 1u);
            const unsigned tg = og / nx;
            if (og + 1u == (tg + 1u) * nx) xb_add(&bar[XB_TOPGEN], 1u);
            else XB_SPIN(xb_ld(&bar[XB_TOPGEN]) == tg, bar);
            __builtin_amdgcn_fence(__ATOMIC_ACQUIRE, "agent");
            xb_add(&bar[XB_XGEN(b.x)], 1u);
            asm volatile("s_waitcnt vmcnt(0)" ::: "memory");
        } else {
            XB_SPIN(xb_ld(&bar[XB_XGEN(b.x)]) == gen, bar);
            __builtin_amdgcn_fence(__ATOMIC_ACQUIRE, "agent");
            asm volatile("s_waitcnt vmcnt(0)" ::: "memory");
        }
    }
    __syncthreads();
}

constexpr int RING_BYTES = 131072, MISC_OFF = RING_BYTES + 320, LDS_BYTES = 147456;
constexpr size_t WS_BAR = 65536;
static_assert(attn_body::LDS_BYTES <= RING_BYTES, "attention scratch");

struct Args { const float* in[16]; float* out; unsigned char* ws; };
enum { I_X = 0, I_GPRE, I_WIN, I_SW, I_SB, I_SG, I_GQ, I_GK, I_GMIX, I_WOUT, I_GPOSTM, I_GPREF, I_WG, I_WU, I_WD, I_GPOSTF };

__device__ __forceinline__ void transpose_item(const float* W, int ldw, int k0, int n0, bf16_t* WT, int ldt, int drow0, LAS float* scr, int lane) {
#pragma unroll 8
    for (int i = 0; i < 32; ++i) { const int kk = 2 * i + (lane >> 5); scr[kk * 33 + (lane & 31)] = W[(size_t)(k0 + kk) * ldw + n0 + (lane & 31)]; }
    asm volatile("s_waitcnt lgkmcnt(0)" ::: "memory");
    const int c = lane & 7;
#pragma unroll
    for (int j = 0; j < 4; ++j) { const int n = (lane >> 3) + 8 * j; const LAS float* s = scr + (8 * c) * 33 + n;
        u32x4 o; o.x = pk2(s[0 * 33], s[1 * 33]); o.y = pk2(s[2 * 33], s[3 * 33]); o.z = pk2(s[4 * 33], s[5 * 33]); o.w = pk2(s[6 * 33], s[7 * 33]);
        *(u32x4*)(WT + (size_t)(drow0 + n) * ldt + k0 + 8 * c) = o; }
    asm volatile("s_waitcnt lgkmcnt(0)" ::: "memory");
}

__device__ __forceinline__ void resnorm_row(const bf16_t* mrow, const float* base, float* out, const float* gpost, const float* gnext, bf16_t* xn, int lane) {
    f32x4 xv[4]; float mv[4][4]; float ss = 0.f;
#pragma unroll
    for (int j = 0; j < 4; ++j) { const u32x2 w = *(const u32x2*)(mrow + 256 * j + 4 * lane); xv[j] = *(const f32x4*)(base + 256 * j + 4 * lane);
        mv[j][0] = bflo(w.x); mv[j][1] = bfhi(w.x); mv[j][2] = bflo(w.y); mv[j][3] = bfhi(w.y);
        ss += (mv[j][0] * mv[j][0] + mv[j][1] * mv[j][1]) + (mv[j][2] * mv[j][2] + mv[j][3] * mv[j][3]); }
    const float r1 = 1.0f / sqrtf(wave_sum(ss) * (1.0f / 1024.0f) + EPS); float s2 = 0.f;
#pragma unroll
    for (int j = 0; j < 4; ++j) { const f32x4 g = *(const f32x4*)(gpost + 256 * j + 4 * lane);
#pragma unroll
        for (int e = 0; e < 4; ++e) { xv[j][e] += mv[j][e] * r1 * g[e]; s2 += xv[j][e] * xv[j][e]; }
        *(f32x4*)(out + 256 * j + 4 * lane) = xv[j]; }
    if (xn) { const float r2 = 1.0f / sqrtf(wave_sum(s2) * (1.0f / 1024.0f) + EPS);
#pragma unroll
        for (int j = 0; j < 4; ++j) { const f32x4 g = *(const f32x4*)(gnext + 256 * j + 4 * lane);
            u32x2 w; w.x = pk2(xv[j][0] * r2 * g[0], xv[j][1] * r2 * g[1]); w.y = pk2(xv[j][2] * r2 * g[2], xv[j][3] * r2 * g[3]);
            *(u32x2*)(xn + 256 * j + 4 * lane) = w; } }
}

__device__ __forceinline__ void sgu_unit(int unit, const bf16_t* Z, const float* Ws, const float* bs, const float* gv, const float* gmix, bf16_t* Y, LAS unsigned char* lds, int tid) {
    const int lane = tid & 63, w = __builtin_amdgcn_readfirstlane(tid >> 6), fr = lane & 15, fq = lane >> 4;
    const int row0 = unit * 128;
    constexpr int VTP = 272;
    LAS unsigned char* VT = lds; LAS float* SS = (LAS float*)(lds + 256 * VTP);
    {
        const int r = tid >> 2, qd = tid & 3;
        const bf16_t* vp = Z + (size_t)(row0 + r) * ZP + ZC_V + 64 * qd;
        u32x4 raw[8]; float s = 0.f;
#pragma unroll
        for (int j = 0; j < 8; ++j) { raw[j] = *(const u32x4*)(vp + 8 * j);
#pragma unroll
            for (int e = 0; e < 4; ++e) s += bflo(raw[j][e]) + bfhi(raw[j][e]); }
        s += __shfl_xor(s, 1); s += __shfl_xor(s, 2);
        const float mu = s * (1.0f / 256.0f); float q = 0.f;
#pragma unroll
        for (int j = 0; j < 8; ++j)
#pragma unroll
            for (int e = 0; e < 4; ++e) { const float a = bflo(raw[j][e]) - mu, b = bfhi(raw[j][e]) - mu; q += a * a + b * b; }
        q += __shfl_xor(q, 1); q += __shfl_xor(q, 2);
        const float rstd = 1.0f / sqrtf(q * (1.0f / 256.0f) + EPS);
#pragma unroll
        for (int j = 0; j < 8; ++j)
#pragma unroll
            for (int e = 0; e < 4; ++e) { const int c = 64 * qd + 8 * j + 2 * e;
                const float a = (bflo(raw[j][e]) - mu) * rstd * gv[c], b = (bfhi(raw[j][e]) - mu) * rstd * gv[c + 1];
                *(LAS bf16_t*)(VT + c * VTP + r * 2) = (bf16_t)f2bf(a); *(LAS bf16_t*)(VT + (c + 1) * VTP + r * 2) = (bf16_t)f2bf(b); }
    }
    __syncthreads();
    const int h = w >> 1, cbase = 64 * h + 32 * (w & 1);
    bf16x8 bfr[2][4];
#pragma unroll
    for (int n = 0; n < 2; ++n)
#pragma unroll
        for (int kk = 0; kk < 4; ++kk) bfr[n][kk] = *(const LAS bf16x8*)(VT + (cbase + 16 * n + fr) * VTP + (32 * kk + 8 * fq) * 2);
    f32x4 acc[8][2];
    const float* Wh = Ws + (size_t)h * 128 * 128;
#pragma unroll
    for (int m = 0; m < 8; ++m) {
        acc[m][0] = (f32x4){0.f, 0.f, 0.f, 0.f}; acc[m][1] = (f32x4){0.f, 0.f, 0.f, 0.f};
#pragma unroll
        for (int kk = 0; kk < 4; ++kk) {
            const float* ap = Wh + (size_t)(16 * m + fr) * 128 + 32 * kk + 8 * fq;
            const f32x4 a0 = *(const f32x4*)ap, a1 = *(const f32x4*)(ap + 4);
            u32x4 aw; aw.x = pk2(a0[0], a0[1]); aw.y = pk2(a0[2], a0[3]); aw.z = pk2(a1[0], a1[1]); aw.w = pk2(a1[2], a1[3]);
            const bf16x8 af = __builtin_bit_cast(bf16x8, aw);
            acc[m][0] = __builtin_amdgcn_mfma_f32_16x16x32_bf16(bfr[0][kk], af, acc[m][0], 0, 0, 0);
            acc[m][1] = __builtin_amdgcn_mfma_f32_16x16x32_bf16(bfr[1][kk], af, acc[m][1], 0, 0, 0);
        }
    }
#pragma unroll
    for (int m = 0; m < 8; ++m) { const int p = 16 * m + fr; const float bias = bs[h * 128 + p]; float ss = 0.f;
#pragma unroll
        for (int n = 0; n < 2; ++n) { const int c = cbase + 16 * n + 4 * fq; const u32x2 uw = *(const u32x2*)(Z + (size_t)(row0 + p) * ZP + ZC_U + c);
            f32x4 v = acc[m][n]; v[0] = (v[0] + bias) * bflo(uw.x); v[1] = (v[1] + bias) * bfhi(uw.x); v[2] = (v[2] + bias) * bflo(uw.y); v[3] = (v[3] + bias) * bfhi(uw.y);
            acc[m][n] = v; ss += (v[0] * v[0] + v[1] * v[1]) + (v[2] * v[2] + v[3] * v[3]); }
        ss += __shfl_xor(ss, 16); ss += __shfl_xor(ss, 32);
        if (fq == 0) SS[w * 128 + p] = ss; }
    __syncthreads();
#pragma unroll
    for (int m = 0; m < 8; ++m) { const int p = 16 * m + fr; float tot = 0.f;
#pragma unroll
        for (int ww = 0; ww < 8; ++ww) tot += SS[ww * 128 + p];
        const float rr = 1.0f / sqrtf(tot * (1.0f / 256.0f) + EPS);
#pragma unroll
        for (int n = 0; n < 2; ++n) { const int c = cbase + 16 * n + 4 * fq; const f32x4 g = *(const f32x4*)(gmix + 256 + c); const f32x4 v = acc[m][n];
            u32x2 ow; ow.x = pk2(v[0] * rr * g[0], v[1] * rr * g[1]); ow.y = pk2(v[2] * rr * g[2], v[3] * rr * g[3]);
            *(u32x2*)(Y + (size_t)(row0 + p) * DM + 256 + c) = ow; } }
    __syncthreads();
}

__global__ void __launch_bounds__(NTHR, 2) hybrid_fwd(Args args) {
    extern __shared__ __attribute__((aligned(16))) unsigned char lds_raw[];
    cg::grid_group grid = cg::this_grid();
    LAS unsigned char* lds = (LAS unsigned char*)lds_raw;
    const int tid = threadIdx.x, lane = tid & 63, wave = __builtin_amdgcn_readfirstlane(tid >> 6);
    const int G = gridDim.x; const int bx = blockIdx.x; const int vcu = (G % 8 == 0) ? (bx % 8) * (G / 8) + bx / 8 : bx;
    const int gw = vcu * NWAVES + wave, NGW = G * NWAVES;
    unsigned char* ws = args.ws;
    float* ropec = (float*)(ws + WS_CTL); float* ropes = ropec + 1024;
    bf16_t* XN = (bf16_t*)(ws + WS_XN); bf16_t* MB = (bf16_t*)(ws + WS_MB); float* PP = (float*)(ws + WS_MB);
    bf16_t* HB = (bf16_t*)(ws + WS_H); bf16_t* Zm = (bf16_t*)(ws + WS_Z); bf16_t* ZFt = (bf16_t*)(ws + WS_ZF); bf16_t* OB = (bf16_t*)(ws + WS_O); bf16_t* Y = (bf16_t*)(ws + WS_Y);
    bf16_t* DFTM = (bf16_t*)(ws + WS_DFT);
    const float* x_in = args.in[I_X]; float* out = args.out;

    unsigned* barw = (unsigned*)(ws + WS_BAR);
    volatile LAS unsigned* MISC = (volatile LAS unsigned*)(lds + MISC_OFF);
    if (bx == 0) for (int i = tid; i < XCD_BAR_WORDS; i += NTHR) __hip_atomic_store(barw + i, 0u, __ATOMIC_RELAXED, __HIP_MEMORY_SCOPE_AGENT);
    if (tid < 2) MISC[tid] = 0u;
    {
        LAS float* scr = (LAS float*)(lds + wave * 16384);
        constexpr int IT_IN = 16 * 40, IT_OUT = 16 * 32, IT_G = 16 * 88, IT_D = 44 * 32, IT_L = IT_IN + IT_OUT + 2 * IT_G + IT_D;
        for (int it = gw; it < DEPTH * IT_L; it += NGW) {
            const int l = it / IT_L; int r = it % IT_L; unsigned char* wl = ws + WS_W + (size_t)l * WL_SIZE;
            if (r < IT_IN) { const int kb = r / 40, nb = r % 40; transpose_item(args.in[I_WIN] + (size_t)l * DM * DIN, DIN, 64 * kb, 256 + 32 * nb, (bf16_t*)(wl + WL_IN), DM, 32 * nb, scr, lane); continue; } r -= IT_IN;
            if (r < IT_OUT) { const int kb = r / 32, nb = r % 32; transpose_item(args.in[I_WOUT] + (size_t)l * DM * DM, DM, 64 * kb, 32 * nb, (bf16_t*)(wl + WL_OUT), DM, 32 * nb, scr, lane); continue; } r -= IT_OUT;
            if (r < 2 * IT_G) { const int up = r >= IT_G; if (up) r -= IT_G; const int kb = r / 88, nb = r % 88; const int n0 = 32 * nb;
                transpose_item(args.in[up ? I_WU : I_WG] + (size_t)l * DM * DFF, DFF, 64 * kb, n0, (bf16_t*)(wl + WL_GU), DM, 256 * (n0 >> 7) + (n0 & 127) + (up ? 128 : 0), scr, lane); continue; } r -= 2 * IT_G;
            { const int kb = r / 32, nb = r % 32; transpose_item(args.in[I_WD] + (size_t)l * DFF * DM, DM, 64 * kb, 32 * nb, (bf16_t*)(wl + WL_DN), DFF, 32 * nb, scr, lane); }
        }
        {
            float sn64, cs64; sincospif((float)lane * (1.0f / 32.0f), &sn64, &cs64);
            for (int it = gw; it < DEPTH * 4096; it += NGW) {
                const int l = it >> 12, k = (it & 4095) >> 2, g = it & 3;
                const float wv = args.in[I_WIN][(size_t)l * DM * DIN + (size_t)k * DIN + 64 * g + lane];
                float ac = 0.f, as = 0.f;
#pragma unroll 8
                for (int c = 0; c < 64; ++c) { const float wc = __shfl(wv, c); const int idx = (c * lane) & 63; ac += wc * __shfl(cs64, idx); as += wc * __shfl(sn64, idx); }
                bf16_t* wf = (bf16_t*)(ws + WS_W + (size_t)l * WL_SIZE + WL_F);
                wf[(size_t)(64 * g + lane) * DM + k] = (bf16_t)f2bf(ac); wf[(size_t)(256 + 64 * g + lane) * DM + k] = (bf16_t)f2bf(as);
            }
        }
        if (bx == 0) { for (int i = tid; i < 1024; i += NTHR) { const int p = i >> 4, j = i & 15; const float fr_ = powf(10000.0f, -(float)j / 16.0f); const float ang = (float)p * fr_; ropec[i] = cosf(ang); ropes[i] = sinf(ang); } }
        { int lane_ = lane; asm volatile("" : "+v"(lane_)); const int lane = lane_;
        for (int m = gw; m < MTOK; m += NGW) {
            const float* xr = x_in + (size_t)m * DM; f32x4 v[4]; float ss = 0.f;
#pragma unroll
            for (int j = 0; j < 4; ++j) { v[j] = *(const f32x4*)(xr + 256 * j + 4 * lane); ss += (v[j][0] * v[j][0] + v[j][1] * v[j][1]) + (v[j][2] * v[j][2] + v[j][3] * v[j][3]); }
            const float r = 1.0f / sqrtf(wave_sum(ss) * (1.0f / 1024.0f) + EPS);
#pragma unroll
            for (int j = 0; j < 4; ++j) { const f32x4 g = *(const f32x4*)(args.in[I_GPRE] + 256 * j + 4 * lane);
                u32x2 w; w.x = pk2(v[j][0] * r * g[0], v[j][1] * r * g[1]); w.y = pk2(v[j][2] * r * g[2], v[j][3] * r * g[3]);
                *(u32x2*)(XN + (size_t)m * DM + 256 * j + 4 * lane) = w; }
        } }
        __syncthreads();
        {
            LAS unsigned* tab = (LAS unsigned*)lds;
            for (int j = tid; j < 4096; j += NTHR) { float s, c; sincospif((float)j * (1.0f / 2048.0f), &s, &c); tab[j] = f2bf(c) | (f2bf(-s) << 16); }
            __syncthreads();
            for (int it = vcu * NTHR + tid; it < 4096 * 512; it += G * NTHR) { const int k = it >> 9, n0 = (it & 511) * 8;
                unsigned t[8];
#pragma unroll
                for (int e = 0; e < 8; ++e) t[e] = tab[(k * (n0 + e)) & 4095];
                u32x4 cw, sw;
                cw.x = (t[0] & 0xffffu) | (t[1] << 16); cw.y = (t[2] & 0xffffu) | (t[3] << 16); cw.z = (t[4] & 0xffffu) | (t[5] << 16); cw.w = (t[6] & 0xffffu) | (t[7] << 16);
                sw.x = (t[0] >> 16) | (t[1] & 0xffff0000u); sw.y = (t[2] >> 16) | (t[3] & 0xffff0000u); sw.z = (t[4] >> 16) | (t[5] & 0xffff0000u); sw.w = (t[6] >> 16) | (t[7] & 0xffff0000u);
                *(u32x4*)(DFTM + (size_t)k * 4096 + n0) = cw; *(u32x4*)(DFTM + (size_t)4096 * 4096 + (size_t)k * 4096 + n0) = sw; }
            __syncthreads();
        }
    }
    grid.sync();
    const XcdBarrier xbar = xcd_barrier_post(barw, MISC);
#define GSYNC() xcd_barrier(xbar)

#pragma unroll 1
    for (int l = 0; l < DEPTH; ++l) {
        unsigned char* wl = ws + WS_W + (size_t)l * WL_SIZE;
        const float* gmix = args.in[I_GMIX] + l * 1024;
        {
            pg8::Gemm g{XN, (const bf16_t*)(wl + WL_IN), DM, DM, DM}; pg8::StaticOrder S; S.init(MTOK, 1280, G, bx);
            pg8::EpiBf16<1> E{Zm, ZP};
            pg8::gemm_phase<pg8::EpiBf16<1>, pg8::StaticOrder, true>(lds, g, S, E);
        }
        {
            pg8::Gemm g{(const bf16_t*)(wl + WL_F), XN, DM, DM, DM}; pg8::StaticOrder S; S.init(512, MTOK, G, G - 1 - bx);
            pg8::EpiBf16<0> E{ZFt, MTOK};
            pg8::gemm_phase<pg8::EpiBf16<0>, pg8::StaticOrder, true>(lds, g, S, E);
        }
        GSYNC();
        {
            const float* gk = args.in[I_GK] + l * 64;
            { int lane_ = lane; asm volatile("" : "+v"(lane_)); const int lane = lane_;
            for (int m = gw; m < MTOK; m += NGW) {
                const int hh = lane >> 5, j = lane & 31, t = j >> 4, i = j & 15;
                bf16_t* kp = Zm + (size_t)m * ZP + ZC_K + hh * 64 + 32 * t + i;
                const float a = bflo((unsigned)kp[0]), b = bflo((unsigned)kp[16]);
                float ss = a * a + b * b;
#pragma unroll
                for (int o = 1; o < 32; o <<= 1) ss += __shfl_xor(ss, o);
                const float r = 1.0f / sqrtf(ss * (1.0f / 64.0f) + EPS);
                const int pos = m & (SEQ - 1), pp = t ? (pos & 63) : (pos >> 6);
                const float cs = ropec[pp * 16 + i], sn = ropes[pp * 16 + i];
                const float x1 = a * r * gk[32 * t + i], x2 = b * r * gk[32 * t + 16 + i];
                kp[0] = (bf16_t)f2bf(x1 * cs - x2 * sn); kp[16] = (bf16_t)f2bf(x2 * cs + x1 * sn);
            } }
            int tid_ = tid; asm volatile("" : "+v"(tid_));
            for (int u = vcu; u < MTOK / 128; u += G)
                sgu_unit(u, Zm, args.in[I_SW] + (size_t)l * 4 * 128 * 128, args.in[I_SB] + l * 512, args.in[I_SG] + l * 256, gmix, Y, lds, tid_);
            for (int u = vcu; u < 256; u += G) {
                const int part = u >> 7, b = (u >> 4) & 7, mt = u & 15;
                pg8::Gemm g{DFTM + (size_t)part * 4096 * 4096, ZFt + (size_t)part * 256 * MTOK + (size_t)b * SEQ, 4096, MTOK, 4096};
                pg8::OneUnit S{mt, 0, 1};
                pg8::EpiF32 E{PP + (size_t)part * MTOK * 256 + (size_t)b * SEQ * 256, 256, 1.0f / 512.0f};
                pg8::gemm_phase<pg8::EpiF32, pg8::OneUnit, false>(lds, g, S, E);
            }
        }
        GSYNC();
        {
            const float* gq = args.in[I_GQ] + l * 64;
            for (int idx = vcu; idx < 1024; idx += G) {
                const int x = (idx & 255) >> 5, j = idx & 31, i = idx >> 8, lu = i * 32 + j, pair = 2 * x + (lu >> 6), wi = lu & 63;
                const int b = pair >> 1, kvh = pair & 1, h = kvh * 4 + (wi >> 4), qb = wi & 15;
                attn_body::attn_unit<8>(b, h, qb, (const attn_body::bf16*)Zm, (attn_body::bf16*)OB, gq, ropec, ropes, (char*)lds_raw);
            }
        }
        GSYNC();
        { int lane_ = lane; asm volatile("" : "+v"(lane_)); const int lane = lane_;
        for (int m = gw; m < MTOK; m += NGW) {
            { const f32x4 p0 = *(const f32x4*)(PP + (size_t)m * 256 + 4 * lane), p1 = *(const f32x4*)(PP + (size_t)MTOK * 256 + (size_t)m * 256 + 4 * lane);
              const f32x4 y = p0 + p1; const float ss = wave_sum((y[0] * y[0] + y[1] * y[1]) + (y[2] * y[2] + y[3] * y[3]));
              const float r = 1.0f / sqrtf(ss * (1.0f / 256.0f) + EPS); const f32x4 g = *(const f32x4*)(gmix + 4 * lane);
              u32x2 w; w.x = pk2(y[0] * r * g[0], y[1] * r * g[1]); w.y = pk2(y[2] * r * g[2], y[3] * r * g[3]);
              *(u32x2*)(Y + (size_t)m * DM + 4 * lane) = w; }
            { const u32x4 ow = *(const u32x4*)(OB + (size_t)m * OP + 8 * lane); float v[8];
#pragma unroll
              for (int e = 0; e < 4; ++e) { v[2 * e] = bflo(ow[e]); v[2 * e + 1] = bfhi(ow[e]); }
              float ss = 0.f;
#pragma unroll
              for (int e = 0; e < 8; ++e) ss += v[e] * v[e];
              const float r = 1.0f / sqrtf(wave_sum(ss) * (1.0f / 512.0f) + EPS);
              const f32x4 g0 = *(const f32x4*)(gmix + 512 + 8 * lane), g1 = *(const f32x4*)(gmix + 512 + 8 * lane + 4);
              u32x4 w; w.x = pk2(v[0] * r * g0[0], v[1] * r * g0[1]); w.y = pk2(v[2] * r * g0[2], v[3] * r * g0[3]); w.z = pk2(v[4] * r * g1[0], v[5] * r * g1[1]); w.w = pk2(v[6] * r * g1[2], v[7] * r * g1[3]);
              *(u32x4*)(Y + (size_t)m * DM + 512 + 8 * lane) = w; }
        } }
        GSYNC();
        {
            pg8::Gemm g{Y, (const bf16_t*)(wl + WL_OUT), DM, DM, DM}; pg8::StaticOrder S; S.init(MTOK, DM, G, bx);
            pg8::EpiBf16<0> E{MB, DM};
            pg8::gemm_phase<pg8::EpiBf16<0>, pg8::StaticOrder, true>(lds, g, S, E);
        }
        GSYNC();
        { int lane_ = lane; asm volatile("" : "+v"(lane_));
        for (int m = gw; m < MTOK; m += NGW)
            resnorm_row(MB + (size_t)m * DM, (l == 0 ? x_in : out) + (size_t)m * DM, out + (size_t)m * DM, args.in[I_GPOSTM] + l * DM, args.in[I_GPREF] + l * DM, XN + (size_t)m * DM, lane_); }
        GSYNC();
        {
            pg8::Gemm g{XN, (const bf16_t*)(wl + WL_GU), DM, DM, DM}; pg8::StaticOrder S; S.init(MTOK, 2 * DFF, G, bx);
            pg8::EpiSwiglu E{HB, DFF};
            pg8::gemm_phase<pg8::EpiSwiglu, pg8::StaticOrder, true>(lds, g, S, E);
        }
        GSYNC();
        {
            pg8::Gemm g{HB, (const bf16_t*)(wl + WL_DN), DFF, DFF, DFF}; pg8::StaticOrder S; S.init(MTOK, DM, G, bx);
            pg8::EpiBf16<0> E{MB, DM};
            pg8::gemm_phase<pg8::EpiBf16<0>, pg8::StaticOrder, true>(lds, g, S, E);
        }
        GSYNC();
        {
            const bool more = (l + 1 < DEPTH);
            int lane_ = lane; asm volatile("" : "+v"(lane_));
            for (int m = gw; m < MTOK; m += NGW)
                resnorm_row(MB + (size_t)m * DM, out + (size_t)m * DM, out + (size_t)m * DM, args.in[I_GPOSTF] + l * DM, more ? args.in[I_GPRE] + (l + 1) * DM : nullptr, more ? XN + (size_t)m * DM : nullptr, lane_);
            if (more) GSYNC();
        }
    }
}

extern "C" void kernel_launch(void* const* d_in, const int* in_sizes, int n_in, void* d_out, int out_size, void* d_ws, size_t ws_size, hipStream_t stream) {
    static int grid = 0;
    if (grid == 0) {
        if (n_in != 16 || in_sizes[0] != MTOK * DM || out_size != MTOK * DM || ws_size < WS_END) { fprintf(stderr, "kernel_launch: unexpected shapes (n_in %d, in0 %d, out %d, ws %zu)\n", n_in, n_in > 0 ? in_sizes[0] : -1, out_size, ws_size); grid = -1; return; }
        int dev = 0, cus = 0, per_cu = 0;
        hipGetDevice(&dev); hipDeviceGetAttribute(&cus, hipDeviceAttributeMultiprocessorCount, dev);
        hipFuncSetAttribute((const void*)hybrid_fwd, hipFuncAttributeMaxDynamicSharedMemorySize, LDS_BYTES);
        hipOccupancyMaxActiveBlocksPerMultiprocessor(&per_cu, (const void*)hybrid_fwd, NTHR, LDS_BYTES);
        if (per_cu < 1) { fprintf(stderr, "kernel_launch: occupancy query reports %d blocks per CU\n", per_cu); per_cu = 1; }
        (void)hipGetLastError();
        grid = cus * (per_cu > 1 ? 1 : per_cu);
    }
    if (grid < 0) return;
    Args a{};
    for (int i = 0; i < 16; ++i) a.in[i] = (const float*)d_in[i];
    a.out = (float*)d_out; a.ws = (unsigned char*)d_ws;
    void* kargs[] = {&a};
    hipError_t e = hipLaunchCooperativeKernel((const void*)hybrid_fwd, dim3(grid), dim3(NTHR), kargs, LDS_BYTES, stream);
    if (e != hipSuccess) fprintf(stderr, "cooperative launch failed: %s (grid %d)\n", hipGetErrorString(e), grid);
}
```

```cpp
#include <hip/hip_runtime.h>
#include <hip/hip_cooperative_groups.h>
#include <hip/hip_bf16.h>
#include <cstdio>
#include <cstdint>
#include <cmath>
namespace cg = cooperative_groups;

#define LAS __attribute__((address_space(3)))
#define GAS __attribute__((address_space(1)))
typedef unsigned short bf16_t;
typedef short bf16x8 __attribute__((ext_vector_type(8)));
typedef float f32x4 __attribute__((ext_vector_type(4)));
typedef float f32x2 __attribute__((ext_vector_type(2)));
typedef unsigned u32x4 __attribute__((ext_vector_type(4)));
typedef unsigned u32x2 __attribute__((ext_vector_type(2)));

constexpr int NB = 8, SEQ = 4096, DM = 1024, MTOK = NB * SEQ, DIN = 1536, DFF = 2816, DEPTH = 2;
constexpr int ZP = 1280;
constexpr int ZC_U = 0, ZC_V = 256, ZC_Q = 512, ZC_K = 1024, ZC_VA = 1152;
constexpr int OP = 512;
constexpr float EPS = 1e-6f;
constexpr int NWAVES = 8, NTHR = 512;

constexpr size_t MiB = 1u << 20;
constexpr size_t WS_CTL = 0;
constexpr size_t WS_W = 1 * MiB;
constexpr size_t WL_IN = 0, WL_F = (size_t)1280 * 1024 * 2, WL_OUT = WL_F + (size_t)512 * 1024 * 2, WL_GU = WL_OUT + (size_t)1024 * 1024 * 2,
                 WL_DN = WL_GU + (size_t)5632 * 1024 * 2, WL_SIZE = WL_DN + (size_t)1024 * 2816 * 2;
static_assert(WL_SIZE == 22 * MiB, "weights per layer");
constexpr size_t WS_DFT = 48 * MiB;
constexpr size_t WS_XN = 112 * MiB;
constexpr size_t WS_MB = 176 * MiB;
constexpr size_t WS_H = 240 * MiB;
constexpr size_t WS_Z = 240 * MiB, WS_ZF = 320 * MiB, WS_O = 352 * MiB, WS_Y = 384 * MiB, WS_END = 448 * MiB;

__device__ __forceinline__ unsigned f2bf(float f) { unsigned u = __builtin_bit_cast(unsigned, f); return (u + 0x7fffu + ((u >> 16) & 1u)) >> 16; }
__device__ __forceinline__ unsigned pk2(float lo, float hi) { return f2bf(lo) | (f2bf(hi) << 16); }
__device__ __forceinline__ float bflo(unsigned w) { return __builtin_bit_cast(float, w << 16); }
__device__ __forceinline__ float bfhi(unsigned w) { return __builtin_bit_cast(float, w & 0xffff0000u); }
__device__ __forceinline__ float wave_sum(float v) {
#pragma unroll
    for (int o = 1; o < 64; o <<= 1) v += __shfl_xor(v, o);
    return v;
}
__device__ __forceinline__ float gelu_tanh(float x) {
    const float t = 1.5957691216057308f * (x + 0.044715f * x * x * x);
    const float e = __builtin_amdgcn_exp2f(-t * 1.4426950408889634f);
    return x * __builtin_amdgcn_rcpf(1.f + e);
}
__device__ __forceinline__ float silu_f(float x) {
    const float e = __builtin_amdgcn_exp2f(-x * 1.4426950408889634f);
    return x * __builtin_amdgcn_rcpf(1.f + e);
}

namespace pg8 {
constexpr int BM = 256, BK = 64, HALF = 128, HTB = HALF * BK * 2, STAGE_BYTES = 8 * HTB, NXCD = 8, WGM = 8;
__host__ __device__ __forceinline__ int lds_byte(int r, int c) { const int st = (r >> 4) * 2 + (c >> 5), rr = r & 15, cc = c & 31, ob = rr * 64 + cc * 2; return st * 1024 + (ob ^ (((ob >> 9) & 1) << 5)); }
__host__ __device__ __forceinline__ void stage_rc(int b, int& R, int& C) { const int st = b / 1024, sb = b % 1024, swz = sb ^ (((sb >> 9) & 1) << 5); R = (st >> 1) * 16 + swz / 64; C = (st & 1) * 32 + (swz % 64) / 2; }
__host__ __device__ __forceinline__ int perm32(int rho) { const int n = rho >> 4, i = rho & 15; return 8 * (i >> 2) + 4 * n + (i & 3); }

struct Unit { int pm, pn; };
struct Gemm { const bf16_t* A; const bf16_t* Bt; int lda, ldb, K; };

struct StaticOrder {
    int nM, nN, nwg, G, c;
    __device__ void init(int M, int N, int G_, int c_) { nM = M / BM; nN = N / BM; nwg = nM * nN; G = G_; c = c_; }
    __device__ bool next(int i, Unit& u) const {
        const long L = (long)i * G + c; if (L >= nwg) return false;
        int wgid = (int)L; { const int q = nwg / NXCD, r = nwg % NXCD, xcd = wgid % NXCD, off = wgid / NXCD; wgid = (xcd < r ? xcd * (q + 1) : r * (q + 1) + (xcd - r) * q) + off; }
        const int nig = WGM * nN, gid = wgid / nig, fm = gid * WGM, gsz = (nM - fm) < WGM ? (nM - fm) : WGM;
        u.pm = fm + ((wgid % nig) % gsz); u.pn = (wgid % nig) / gsz; return true;
    }
};
struct OneUnit {
    int pm, pn, have;
    __device__ bool next(int i, Unit& u) const { if (i != 0 || !have) return false; u.pm = pm; u.pn = pn; return true; }
};

__device__ __forceinline__ unsigned cvt_pk_bf16(float lo, float hi) { unsigned r; asm volatile("v_cvt_pk_bf16_f32 %0, %1, %2" : "=v"(r) : "v"(lo), "v"(hi)); return r; }

template <int ACT  > struct EpiBf16 {
    static constexpr bool PERM = true;
    bf16_t* O; int ldc;
    __device__ __forceinline__ void operator()(const f32x4 (&acc)[2][2][4][2], const Unit& u, int wr, int wc, int fr, int fq) const {
        const int row0 = u.pm * BM + wr * 64 + fr; const int col0 = u.pn * BM + wc * 32 + 8 * fq;
        const bool act = (ACT == 1) && (u.pn < 2);
#pragma unroll
        for (int ai = 0; ai < 2; ++ai)
#pragma unroll
            for (int m = 0; m < 4; ++m) { bf16_t* rowp = O + (size_t)(row0 + ai * HALF + m * 16) * ldc + col0;
#pragma unroll
                for (int bj = 0; bj < 2; ++bj) { f32x4 v0 = acc[ai][bj][m][0], v1 = acc[ai][bj][m][1];
                    if (act) {
#pragma unroll
                        for (int e = 0; e < 4; ++e) { v0[e] = gelu_tanh(v0[e]); v1[e] = gelu_tanh(v1[e]); } }
                    u32x4 w; w.x = cvt_pk_bf16(v0[0], v0[1]); w.y = cvt_pk_bf16(v0[2], v0[3]); w.z = cvt_pk_bf16(v1[0], v1[1]); w.w = cvt_pk_bf16(v1[2], v1[3]);
                    *(u32x4*)(rowp + bj * HALF) = w; } }
    }
};
struct EpiSwiglu {
    static constexpr bool PERM = true;
    bf16_t* O; int ldc;
    __device__ __forceinline__ void operator()(const f32x4 (&acc)[2][2][4][2], const Unit& u, int wr, int wc, int fr, int fq) const {
        const int row0 = u.pm * BM + wr * 64 + fr; const int col0 = u.pn * HALF + wc * 32 + 8 * fq;
#pragma unroll
        for (int ai = 0; ai < 2; ++ai)
#pragma unroll
            for (int m = 0; m < 4; ++m) { bf16_t* rowp = O + (size_t)(row0 + ai * HALF + m * 16) * ldc + col0;
                f32x4 v0, v1;
#pragma unroll
                for (int e = 0; e < 4; ++e) { v0[e] = silu_f(acc[ai][0][m][0][e]) * acc[ai][1][m][0][e]; v1[e] = silu_f(acc[ai][0][m][1][e]) * acc[ai][1][m][1][e]; }
                u32x4 w; w.x = cvt_pk_bf16(v0[0], v0[1]); w.y = cvt_pk_bf16(v0[2], v0[3]); w.z = cvt_pk_bf16(v1[0], v1[1]); w.w = cvt_pk_bf16(v1[2], v1[3]);
                *(u32x4*)rowp = w; }
    }
};
struct EpiF32 {
    static constexpr bool PERM = false;
    float* O; int ldc; float scale;
    __device__ __forceinline__ void operator()(const f32x4 (&acc)[2][2][4][2], const Unit& u, int wr, int wc, int fr, int fq) const {
        const int row0 = u.pm * BM + wr * 64 + fr; const int col0 = u.pn * BM + wc * 32 + 4 * fq;
#pragma unroll
        for (int ai = 0; ai < 2; ++ai)
#pragma unroll
            for (int m = 0; m < 4; ++m) { float* rowp = O + (size_t)(row0 + ai * HALF + m * 16) * ldc + col0;
#pragma unroll
                for (int bj = 0; bj < 2; ++bj)
#pragma unroll
                    for (int n = 0; n < 2; ++n) *(f32x4*)(rowp + bj * HALF + n * 16) = acc[ai][bj][m][n] * scale; }
    }
};

template <class Epi, class Sched, bool ALIGN_EPI>
__device__ __forceinline__ void gemm_phase(LAS unsigned char* lds, const Gemm g, const Sched& S, const Epi& E) {
    int tid_l = threadIdx.x; asm volatile("" : "+v"(tid_l));
    const int tid = tid_l, wid = __builtin_amdgcn_readfirstlane(tid >> 6), lane = tid & 63, wr = wid >> 2, wc = wid & 3, fr = lane & 15, fq = lane >> 4;
    const int K = g.K, nt = K / BK;
    unsigned voffA[2], voffB[2];
#pragma unroll
    for (int i = 0; i < 2; ++i) { int R, C; stage_rc(tid * 16 + i * 8192, R, C); const int Rb = Epi::PERM ? ((R & ~31) + perm32(R & 31)) : R;
        voffA[i] = (unsigned)(R * g.lda + C) * 2u; voffB[i] = (unsigned)(Rb * g.ldb + C) * 2u; }
    const size_t kstep = (size_t)(BK * 2);
    const size_t hstepA = (size_t)HALF * g.lda * 2, hstepB = (size_t)HALF * g.ldb * 2;
    const size_t tstepA = 2 * hstepA, tstepB = 2 * hstepB;
    const unsigned ldsw = (unsigned)wid * 1024u;
    const int aoff = lds_byte(wr * 64 + fr, fq * 8), boff = lds_byte(wc * 32 + fr, fq * 8);
#define PG8_SA(b, h) (((b) * 2 + (h)) * HTB)
#define PG8_SB(b, h) ((4 + (b) * 2 + (h)) * HTB)
#define PG8_STAGE(bufoff, gbase, voff) do { _Pragma("unroll") for (int _i = 0; _i < 2; ++_i) \
        __builtin_amdgcn_global_load_lds((const unsigned*)((const char*)(gbase) + (voff)[_i]), (LAS unsigned*)(lds + (bufoff) + ldsw + _i * 8192), 16, 0, 0); } while (0)
#define PG8_LDA(dst, b, h) do { _Pragma("unroll") for (int m = 0; m < 4; ++m) _Pragma("unroll") for (int k = 0; k < 2; ++k) dst[m][k] = *(const LAS bf16x8*)(lds + PG8_SA(b, h) + aoff + m * 2048 + k * 1024); } while (0)
#define PG8_LDB(dst, b, h) do { _Pragma("unroll") for (int n = 0; n < 2; ++n) _Pragma("unroll") for (int k = 0; k < 2; ++k) dst[n][k] = *(const LAS bf16x8*)(lds + PG8_SB(b, h) + boff + n * 2048 + k * 1024); } while (0)
#define PG8_MMA(ai, bj, At, Bt) do { __builtin_amdgcn_s_setprio(1); _Pragma("unroll") for (int m = 0; m < 4; ++m) _Pragma("unroll") for (int n = 0; n < 2; ++n) _Pragma("unroll") for (int k = 0; k < 2; ++k) \
        acc[ai][bj][m][n] = __builtin_amdgcn_mfma_f32_16x16x32_bf16(Bt[n][k], At[m][k], acc[ai][bj][m][n], 0, 0, 0); __builtin_amdgcn_s_setprio(0); } while (0)
#define PG8_WAIT_V(n) asm volatile("s_waitcnt vmcnt(" #n ")" ::: "memory")
#define PG8_WAIT_L(n) asm volatile("s_waitcnt lgkmcnt(" #n ")" ::: "memory")
#define PG8_BAR __builtin_amdgcn_s_barrier()
#define PG8_SCHED __builtin_amdgcn_sched_barrier(0)
    Unit cur, nxt; int ui = 0;
    if (!S.next(0, cur)) return;
    f32x4 acc[2][2][4][2];
#pragma unroll
    for (int a = 0; a < 2; ++a)
#pragma unroll
        for (int b = 0; b < 2; ++b)
#pragma unroll
            for (int m = 0; m < 4; ++m)
#pragma unroll
                for (int n = 0; n < 2; ++n) acc[a][b][m][n] = (f32x4){0.f, 0.f, 0.f, 0.f};
    bf16x8 At[4][2], B0[2][2], B1[2][2];
    const char* cA = (const char*)g.A + (size_t)cur.pm * tstepA; const char* cB = (const char*)g.Bt + (size_t)cur.pn * tstepB;
    PG8_STAGE(PG8_SB(0, 0), cB, voffB); PG8_STAGE(PG8_SB(0, 1), cB + hstepB, voffB); PG8_STAGE(PG8_SA(0, 0), cA, voffA); PG8_STAGE(PG8_SA(0, 1), cA + hstepA, voffA);
    if (wr == 1) PG8_BAR;
    PG8_WAIT_V(2); PG8_BAR;
    PG8_STAGE(PG8_SB(1, 0), cB + kstep, voffB); PG8_STAGE(PG8_SA(1, 0), cA + kstep, voffA); PG8_STAGE(PG8_SB(1, 1), cB + hstepB + kstep, voffB);
    PG8_WAIT_V(6); PG8_BAR;
    for (;;) {
        const bool has_next = S.next(ui + 1, nxt);
        const char* nA = has_next ? (const char*)g.A + (size_t)nxt.pm * tstepA : cA; const char* nB = has_next ? (const char*)g.Bt + (size_t)nxt.pn * tstepB : cB;
        for (int t = 0; t < nt; t += 2) {
            const bool last = (t == nt - 2);
            const char* a1 = cA + (size_t)(t + 1) * kstep;
            const char* a2 = last ? nA : cA + (size_t)(t + 2) * kstep; const char* b2 = last ? nB : cB + (size_t)(t + 2) * kstep;
            const char* a3 = a2 + kstep; const char* b3 = b2 + kstep;
            PG8_LDB(B0, 0, 0); PG8_LDB(B1, 0, 1); PG8_SCHED; PG8_LDA(At, 0, 0); PG8_STAGE(PG8_SA(1, 1), a1 + hstepA, voffA);
            PG8_WAIT_V(8); PG8_WAIT_L(0); PG8_BAR; PG8_MMA(0, 0, At, B0); PG8_MMA(0, 1, At, B1); PG8_BAR; PG8_SCHED;
            PG8_LDA(At, 0, 1); PG8_STAGE(PG8_SB(0, 0), b2, voffB); PG8_STAGE(PG8_SB(0, 1), b2 + hstepB, voffB); PG8_STAGE(PG8_SA(0, 0), a2, voffA);
            PG8_WAIT_V(8); PG8_WAIT_L(0); PG8_BAR; PG8_MMA(1, 0, At, B0); PG8_MMA(1, 1, At, B1); PG8_BAR; PG8_SCHED;
            PG8_LDB(B0, 1, 0); PG8_LDB(B1, 1, 1); PG8_SCHED; PG8_LDA(At, 1, 0); PG8_STAGE(PG8_SA(0, 1), a2 + hstepA, voffA);
            PG8_WAIT_V(8); PG8_WAIT_L(0); PG8_BAR; PG8_MMA(0, 0, At, B0); PG8_MMA(0, 1, At, B1); PG8_BAR; PG8_SCHED;
            PG8_LDA(At, 1, 1); PG8_STAGE(PG8_SB(1, 0), b3, voffB); PG8_STAGE(PG8_SB(1, 1), b3 + hstepB, voffB); PG8_STAGE(PG8_SA(1, 0), a3, voffA);
            PG8_WAIT_V(8); PG8_WAIT_L(0); PG8_BAR; PG8_MMA(1, 0, At, B0); PG8_MMA(1, 1, At, B1); PG8_BAR; PG8_SCHED;
        }
        if constexpr (ALIGN_EPI) { if (wr == 0) PG8_BAR; }
        E(acc, cur, wr, wc, fr, fq);
        if (!has_next) break;
#pragma unroll
        for (int a = 0; a < 2; ++a)
#pragma unroll
            for (int b = 0; b < 2; ++b)
#pragma unroll
                for (int m = 0; m < 4; ++m)
#pragma unroll
                    for (int n = 0; n < 2; ++n) acc[a][b][m][n] = (f32x4){0.f, 0.f, 0.f, 0.f};
        cur = nxt; cA = nA; cB = nB; ++ui;
        if constexpr (ALIGN_EPI) { if (wr == 1) PG8_BAR; }
    }
    PG8_WAIT_V(0);
    if constexpr (!ALIGN_EPI) { if (wr == 0) PG8_BAR; }
    PG8_BAR;
#undef PG8_SA
#undef PG8_SB
#undef PG8_STAGE
#undef PG8_LDA
#undef PG8_LDB
#undef PG8_MMA
#undef PG8_WAIT_V
#undef PG8_WAIT_L
#undef PG8_BAR
#undef PG8_SCHED
}
}

namespace attn_body {
using bf16 = __hip_bfloat16;
using s16x4 = __attribute__((ext_vector_type(4))) short;
using f32x16 = __attribute__((ext_vector_type(16))) float;
constexpr int NW = 8, QBLK = 32, QB = QBLK * NW, KVBLK = 64;
__device__ __forceinline__ int crow(int r, int hi) { return (r & 3) + 8 * (r >> 2) + 4 * hi; }
#define SBAR() __builtin_amdgcn_sched_barrier(0)
constexpr int NSLOT = 3, SLOTB = 8192;
constexpr int LDS_K = 0, LDS_V = NSLOT * SLOTB, LDS_WS = 2 * NSLOT * SLOTB, LDS_OST = LDS_WS + NW * 64 * 4, LDS_BYTES = LDS_OST + NW * 4096;
constexpr float C2 = 0.125f * 1.4426950408889634f;
__device__ __forceinline__ void glds16(const void* gsrc, unsigned lds_dst) { unsigned keep;
  asm volatile("s_mov_b32 %0, m0\n\ts_mov_b32 m0, %2\n\ts_nop 0\n\tglobal_load_lds_dwordx4 %1, off\n\ts_mov_b32 m0, %0" : "=&s"(keep) : "v"(gsrc), "s"(lds_dst) : "memory"); }
__device__ __forceinline__ float max3f(float a, float b, float c) { float r; asm("v_max3_f32 %0, %1, %2, %3" : "=v"(r) : "v"(a), "v"(b), "v"(c)); return r; }
__device__ __forceinline__ float max2f(float a, float b) { float r; asm("v_max_f32_e32 %0, %1, %2" : "=v"(r) : "v"(a), "v"(b)); return r; }
__device__ __forceinline__ float fadd_s(float a, float b) { float r; asm("v_add_f32_e32 %0, %1, %2" : "=v"(r) : "v"(a), "v"(b)); return r; }
__device__ __forceinline__ float fsub_s(float a, float b) { float r; asm("v_sub_f32_e32 %0, %1, %2" : "=v"(r) : "v"(a), "v"(b)); return r; }
typedef float f32x2_t __attribute__((ext_vector_type(2))); typedef __bf16 bf16x2_t __attribute__((ext_vector_type(2)));
__device__ __forceinline__ unsigned cvtpk_s(float lo, float hi) { f32x2_t v = {lo, hi}; bf16x2_t b = __builtin_convertvector(v, bf16x2_t); return __builtin_bit_cast(unsigned, b); }
#define WAIT_BAR(N) asm volatile("s_waitcnt vmcnt(" #N ") lgkmcnt(0)\n\ts_barrier" ::: "memory")

__device__ __forceinline__ void qkt(f32x16& p0, f32x16& p1, const char* Kslot, const bf16x8* qr, const f32x16& negm, int r32, int hi) {
  const char* kb = Kslot + hi * 1024 + r32 * 16;
  #pragma unroll
  for (int d0 = 0; d0 < 4; ++d0) {
    const bf16x8 b0 = *reinterpret_cast<const bf16x8*>(kb + d0 * 2048);
    const bf16x8 b1 = *reinterpret_cast<const bf16x8*>(kb + d0 * 2048 + 512);
    if (d0 == 0) { p0 = __builtin_amdgcn_mfma_f32_32x32x16_bf16(b0, qr[0], negm, 0, 0, 0); p1 = __builtin_amdgcn_mfma_f32_32x32x16_bf16(b1, qr[0], negm, 0, 0, 0); }
    else { p0 = __builtin_amdgcn_mfma_f32_32x32x16_bf16(b0, qr[d0], p0, 0, 0, 0); p1 = __builtin_amdgcn_mfma_f32_32x32x16_bf16(b1, qr[d0], p1, 0, 0, 0); } }
}
typedef __attribute__((address_space(3))) const char* lds_cptr;
typedef short v4i16_t __attribute__((ext_vector_type(4)));
__device__ __forceinline__ void kload8(bf16x8* kf, lds_cptr kp) {
  kf[0] = *(const __attribute__((address_space(3))) bf16x8*)(kp);        kf[1] = *(const __attribute__((address_space(3))) bf16x8*)(kp + 512);
  kf[2] = *(const __attribute__((address_space(3))) bf16x8*)(kp + 2048); kf[3] = *(const __attribute__((address_space(3))) bf16x8*)(kp + 2560);
  kf[4] = *(const __attribute__((address_space(3))) bf16x8*)(kp + 4096); kf[5] = *(const __attribute__((address_space(3))) bf16x8*)(kp + 4608);
  kf[6] = *(const __attribute__((address_space(3))) bf16x8*)(kp + 6144); kf[7] = *(const __attribute__((address_space(3))) bf16x8*)(kp + 6656);
}
__device__ __forceinline__ void kload2(bf16x8* kf, lds_cptr kp, int j) { kf[2 * j] = *(const __attribute__((address_space(3))) bf16x8*)(kp + j * 2048); kf[2 * j + 1] = *(const __attribute__((address_space(3))) bf16x8*)(kp + j * 2048 + 512); }
__device__ __forceinline__ s16x4 vtr(lds_cptr p) { return __builtin_bit_cast(s16x4, __builtin_amdgcn_ds_read_tr16_b64_v4i16((__attribute__((address_space(3))) v4i16_t*)p)); }
__device__ __forceinline__ float rowmax(const f32x16& p0, const f32x16& p1) {
  float a = max3f(p0[0], p0[1], p1[0]), b = max3f(p0[2], p0[3], p1[1]); a = max3f(a, p1[2], p1[3]);
  #pragma unroll
  for (int r = 4; r < 16; r += 4) { a = max3f(a, p0[r], p0[r + 1]); b = max3f(b, p0[r + 2], p0[r + 3]); a = max3f(a, p1[r], p1[r + 1]); b = max3f(b, p1[r + 2], p1[r + 3]); }
  const float m = max2f(a, b);
  auto rr = __builtin_amdgcn_permlane32_swap(__float_as_uint(m), __float_as_uint(m), false, false);
  return max2f(__uint_as_float(rr[0]), __uint_as_float(rr[1]));
}
__device__ __forceinline__ void pv(f32x16* o, int vb, bf16x8 pa0, bf16x8 pa1, bf16x8 pa2, bf16x8 pa3) {
  #pragma unroll
  for (int d0 = 0; d0 < 2; ++d0) { s16x4 lo[4], hi[4];
    #pragma unroll
    for (int ks = 0; ks < 4; ++ks) {
      asm volatile("ds_read_b64_tr_b16 %0,%1 offset:%c2" : "=&v"(lo[ks]) : "v"(vb), "i"(d0 * 4096 + ks * 1024) : "memory");
      asm volatile("ds_read_b64_tr_b16 %0,%1 offset:%c2" : "=&v"(hi[ks]) : "v"(vb), "i"(d0 * 4096 + ks * 1024 + 512) : "memory"); }
    asm volatile("s_waitcnt lgkmcnt(0)" ::: "memory"); SBAR();
    #define PK(k) (bf16x8){lo[k][0], lo[k][1], lo[k][2], lo[k][3], hi[k][0], hi[k][1], hi[k][2], hi[k][3]}
    o[d0] = __builtin_amdgcn_mfma_f32_32x32x16_bf16(pa0, PK(0), o[d0], 0, 0, 0);
    o[d0] = __builtin_amdgcn_mfma_f32_32x32x16_bf16(pa1, PK(1), o[d0], 0, 0, 0);
    o[d0] = __builtin_amdgcn_mfma_f32_32x32x16_bf16(pa2, PK(2), o[d0], 0, 0, 0);
    o[d0] = __builtin_amdgcn_mfma_f32_32x32x16_bf16(pa3, PK(3), o[d0], 0, 0, 0);
    #undef PK
  }
}

template <int THRL> __device__ __forceinline__ void attn_unit(int b, int h, int qb, const bf16* Z, bf16* O, const float* gq, const float* ropec, const float* ropes, char* shm) {
  int tid_l = threadIdx.x; asm volatile("" : "+v"(tid_l));
  const int tid = tid_l, lane = tid & 63, r32 = lane & 31, hi = lane >> 5; const int wid = __builtin_amdgcn_readfirstlane(tid >> 6);
  const long rowbase = (long)b * SEQ; const int q0 = qb * QB; const int kvh = h >> 2;
  const bf16* Qw = Z + (rowbase + q0 + wid * QBLK) * ZP + ZC_Q + h * 64;
  const bf16* Kh = Z + rowbase * ZP + ZC_K + kvh * 64, *Vh = Z + rowbase * ZP + ZC_VA + kvh * 64;
  const unsigned lds0 = (unsigned)(uintptr_t)shm;
  float* wsf = (float*)(shm + LDS_WS) + wid * 64;
  const bf16* ksrc = Kh + (long)lane * ZP + wid * 8;
  const bf16* vsrc = Vh + (long)(16 * (wid & 3) + (lane >> 2)) * ZP + (wid >> 2) * 32 + (lane & 3) * 8;
  const unsigned kdst = lds0 + LDS_K + wid * 1024, vdst = lds0 + LDS_V + wid * 1024;
  #define DMA_K(t, slot) glds16(ksrc + (long)(t) * KVBLK * ZP, (unsigned)__builtin_amdgcn_readfirstlane(kdst + (slot)))
  #define DMA_V(t, slot) glds16(vsrc + (long)(t) * KVBLK * ZP, (unsigned)__builtin_amdgcn_readfirstlane(vdst + (slot)))
  const int vb0 = (int)(lds0 + LDS_V) + ((lane >> 4) & 1) * 32 + (lane & 3) * 8 + (4 * hi + ((lane & 15) >> 2)) * 64;
  const char* Kbase = shm + LDS_K; bf16x8 kf[8];
  const lds_cptr shm3 = (lds_cptr)shm; const lds_cptr kp0 = shm3 + LDS_K + hi * 1024 + r32 * 16; const lds_cptr vp0 = shm3 + LDS_V + ((lane >> 4) & 1) * 32 + (lane & 3) * 8 + (4 * hi + ((lane & 15) >> 2)) * 64;
  constexpr int NT = SEQ / KVBLK;
  DMA_K(0, 0); DMA_V(0, 0); DMA_K(1, SLOTB);
  bf16x8 qr[4];
  {
    u32x4 raw[4];
    #pragma unroll
    for (int d0 = 0; d0 < 4; ++d0) raw[d0] = *reinterpret_cast<const u32x4*>(&Qw[(long)r32 * ZP + d0 * 16 + hi * 8]);
    float ss = 0.f;
    #pragma unroll
    for (int d0 = 0; d0 < 4; ++d0)
      #pragma unroll
      for (int e = 0; e < 4; ++e) { const float a = bflo(raw[d0][e]), c = bfhi(raw[d0][e]); ss += a * a + c * c; }
    ss += __shfl_xor(ss, 32);
    const float rinv = 1.0f / sqrtf(ss * (1.0f / 64.0f) + EPS);
    const int pos = q0 + wid * QBLK + r32, prow = pos >> 6, pcol = pos & 63;
    #pragma unroll
    for (int hf = 0; hf < 2; ++hf) {
      const int pp = hf ? pcol : prow;
      u32x4 w1, w2;
      #pragma unroll
      for (int e2 = 0; e2 < 4; ++e2) {
        float o1[2], o2[2];
        #pragma unroll
        for (int s = 0; s < 2; ++s) { const int e = 2 * e2 + s; const int i = 8 * hi + e;
          const float cs = ropec[pp * 16 + i], sn = ropes[pp * 16 + i];
          const unsigned wa = raw[2 * hf][e2], wb = raw[2 * hf + 1][e2];
          const float x1 = (s ? bfhi(wa) : bflo(wa)) * rinv * gq[32 * hf + i], x2 = (s ? bfhi(wb) : bflo(wb)) * rinv * gq[32 * hf + 16 + i];
          o1[s] = (x1 * cs - x2 * sn) * C2; o2[s] = (x2 * cs + x1 * sn) * C2; }
        w1[e2] = cvtpk_s(o1[0], o1[1]); w2[e2] = cvtpk_s(o2[0], o2[1]); }
      qr[2 * hf] = __builtin_bit_cast(bf16x8, w1); qr[2 * hf + 1] = __builtin_bit_cast(bf16x8, w2);
    }
  }
  float mhat = 0.f, l_reg = 0.f; f32x16 o[2]; o[0] = f32x16{}; o[1] = f32x16{}; f32x16 negm = f32x16{}; asm volatile("" : "+v"(negm));
  bool resc = false;
  #define START(P0, P1) do { const float rm = rowmax(P0, P1); resc = false; \
    { const float dl = rm; mhat = fadd_s(mhat, dl); \
      _Pragma("unroll") for (int r = 0; r < 16; ++r) { P0[r] = fsub_s(P0[r], dl); P1[r] = fsub_s(P1[r], dl); } \
      _Pragma("unroll") for (int r = 0; r < 16; ++r) negm[r] = -mhat; asm volatile("" : "+v"(negm)); } \
    _Pragma("unroll") for (int r = 0; r < 16; ++r) P0[r] = __builtin_amdgcn_exp2f(P0[r]); } while (0)
  #define RESC() do { if (resc) { asm volatile("s_waitcnt lgkmcnt(0)" ::: "memory"); \
      _Pragma("unroll") for (int d_ = 0; d_ < 2; ++d_) _Pragma("unroll") for (int r = 0; r < 16; ++r) o[d_][r] *= wsf[crow(r, hi)]; } } while (0)
  f32x16 pA0, pA1, pB0, pB1;
  int sl_prev = 0, sl_cur = 0, sl_next = SLOTB;
  #define ROT() do { sl_prev = sl_cur; sl_cur = sl_next; sl_next = (sl_next == (NSLOT - 1) * SLOTB) ? 0 : sl_next + SLOTB; } while (0)
  DMA_K(2, 2 * SLOTB);
  WAIT_BAR(3);
  qkt(pA0, pA1, Kbase, qr, negm, r32, hi); asm volatile("s_nop 15\n\ts_nop 7" : "+v"(pA0), "+v"(pA1));
  START(pA0, pA1);
  _Pragma("unroll") for (int r = 0; r < 16; ++r) pA1[r] = __builtin_amdgcn_exp2f(pA1[r]);
  WAIT_BAR(0);
  DMA_K(3, 0); DMA_V(1, SLOTB);
  ROT();
  kload8(kf, kp0 + sl_cur);
  WAIT_BAR(2);
  s16x4 vlo[8], vhi[8]; u32x4 pw0, pw1, pw2, pw3;
  #define PKW(P, B) cvtpk_s(P[B], P[B + 1])
  #define PAF(k) __builtin_bit_cast(bf16x8, pw##k)
  #define VFR(i) (bf16x8){vlo[i][0], vlo[i][1], vlo[i][2], vlo[i][3], vhi[i][0], vhi[i][1], vhi[i][2], vhi[i][3]}
  #define PIN(x) asm volatile("" : "+v"(x))
  #define MX3(a, b, c) __builtin_fmaxf(__builtin_fmaxf((a), (b)), (c))
  #define GAPA(MF, A0, A1, A2, A3, W0, W1, PW) do { MF; sacc += A0; sacc += A1; sacc += A2; sacc += A3; PIN(sacc); W0; W1; PIN(PW); SBAR(); } while (0)
  #define EX(v) __builtin_amdgcn_exp2f(v)
  #define GAPB(MF, X, B) do { MF; X[B] = EX(X[B]); X[B + 1] = EX(X[B + 1]); X[B + 2] = EX(X[B + 2]); X[B + 3] = EX(X[B + 3]); PIN(X); SBAR(); } while (0)
  #define VRD(i) do { vlo[i] = vtr(vp_ + (((i) >> 2) * 4096 + ((i) & 3) * 1024)); vhi[i] = vtr(vp_ + (((i) >> 2) * 4096 + ((i) & 3) * 1024 + 512)); } while (0)
  #define KRD(G, j) do { if (G) { kload2(kf, kp0 + sl_next, j); SBAR(); } } while (0)
  #define STEP(C0, C1, P0, P1, t, GK, GV, GL) do { SBAR(); \
    const lds_cptr vp_ = vp0 + sl_prev; \
    VRD(0); SBAR(); float sacc = (P0[0] + P0[1]); \
    GAPA(C0 = __builtin_amdgcn_mfma_f32_32x32x16_bf16(kf[0], qr[0], negm, 0, 0, 0), P0[2], P0[3], P0[4], P0[5],     pw0[0] = PKW(P0, 0), pw0[1] = PKW(P0, 2), pw0); \
    VRD(4); SBAR(); GAPA(C1 = __builtin_amdgcn_mfma_f32_32x32x16_bf16(kf[1], qr[0], negm, 0, 0, 0), P0[6], P0[7], P0[8], P0[9],     pw0[2] = PKW(P0, 4), pw0[3] = PKW(P0, 6), pw0); \
    VRD(1); SBAR(); GAPA(C0 = __builtin_amdgcn_mfma_f32_32x32x16_bf16(kf[2], qr[1], C0, 0, 0, 0),   P0[10], P0[11], P0[12], P0[13], pw1[0] = PKW(P0, 8), pw1[1] = PKW(P0, 10), pw1); \
    VRD(5); SBAR(); GAPA(C1 = __builtin_amdgcn_mfma_f32_32x32x16_bf16(kf[3], qr[1], C1, 0, 0, 0),   P0[14], P0[15], P1[0], P1[1],   pw1[2] = PKW(P0, 12), pw1[3] = PKW(P0, 14), pw1); \
    VRD(2); SBAR(); GAPA(C0 = __builtin_amdgcn_mfma_f32_32x32x16_bf16(kf[4], qr[2], C0, 0, 0, 0),   P1[2], P1[3], P1[4], P1[5],     pw2[0] = PKW(P1, 0), pw2[1] = PKW(P1, 2), pw2); \
    VRD(6); SBAR(); GAPA(C1 = __builtin_amdgcn_mfma_f32_32x32x16_bf16(kf[5], qr[2], C1, 0, 0, 0),   P1[6], P1[7], P1[8], P1[9],     pw2[2] = PKW(P1, 4), pw2[3] = PKW(P1, 6), pw2); \
    VRD(3); SBAR(); GAPA(C0 = __builtin_amdgcn_mfma_f32_32x32x16_bf16(kf[6], qr[3], C0, 0, 0, 0),   P1[10], P1[11], P1[12], P1[13], pw3[0] = PKW(P1, 8), pw3[1] = PKW(P1, 10), pw3); \
    VRD(7); SBAR(); GAPA(C1 = __builtin_amdgcn_mfma_f32_32x32x16_bf16(kf[7], qr[3], C1, 0, 0, 0),   P1[14], P1[15], 0.f, 0.f,       pw3[2] = PKW(P1, 12), pw3[3] = PKW(P1, 14), pw3); \
    l_reg += sacc; \
    if (GK) { DMA_K((t) + 3, sl_cur); } if (GV) { DMA_V((t) + 1, sl_next); } \
    { float a = MX3(C0[0], C0[1], C1[0]), b = MX3(C0[2], C0[3], C1[1]); a = MX3(a, C1[2], C1[3]); \
      _Pragma("unroll") for (int r = 4; r < 16; r += 4) { a = MX3(a, C0[r], C0[r + 1]); b = MX3(b, C0[r + 2], C0[r + 3]); a = MX3(a, C1[r], C1[r + 1]); b = MX3(b, C1[r + 2], C1[r + 3]); } \
      float rm = __builtin_fmaxf(a, b); { auto rr = __builtin_amdgcn_permlane32_swap(__float_as_uint(rm), __float_as_uint(rm), false, false); rm = __builtin_fmaxf(__uint_as_float(rr[0]), __uint_as_float(rr[1])); } \
      resc = false; \
      if (__builtin_expect(__any(rm > (float)THRL), 0)) { const float dl = __builtin_fmaxf(rm, 0.f); mhat += dl; \
        _Pragma("unroll") for (int r = 0; r < 16; ++r) { C0[r] -= dl; C1[r] -= dl; } \
        _Pragma("unroll") for (int r = 0; r < 16; ++r) negm[r] = -mhat; asm volatile("" : "+v"(negm)); \
        const float f = __builtin_amdgcn_exp2f(-dl); l_reg *= f; if (hi == 0) wsf[r32] = f; resc = true; } } \
    SBAR(); \
    GAPB(o[0] = __builtin_amdgcn_mfma_f32_32x32x16_bf16(PAF(0), VFR(0), o[0], 0, 0, 0), C0, 0); \
    GAPB(o[1] = __builtin_amdgcn_mfma_f32_32x32x16_bf16(PAF(0), VFR(4), o[1], 0, 0, 0), C0, 4); \
    KRD(GL, 0); GAPB(o[0] = __builtin_amdgcn_mfma_f32_32x32x16_bf16(PAF(1), VFR(1), o[0], 0, 0, 0), C0, 8); \
    KRD(GL, 1); GAPB(o[1] = __builtin_amdgcn_mfma_f32_32x32x16_bf16(PAF(1), VFR(5), o[1], 0, 0, 0), C0, 12); \
    KRD(GL, 2); GAPB(o[0] = __builtin_amdgcn_mfma_f32_32x32x16_bf16(PAF(2), VFR(2), o[0], 0, 0, 0), C1, 0); \
    KRD(GL, 3); GAPB(o[1] = __builtin_amdgcn_mfma_f32_32x32x16_bf16(PAF(2), VFR(6), o[1], 0, 0, 0), C1, 4); \
    GAPB(o[0] = __builtin_amdgcn_mfma_f32_32x32x16_bf16(PAF(3), VFR(3), o[0], 0, 0, 0), C1, 8); \
    GAPB(o[1] = __builtin_amdgcn_mfma_f32_32x32x16_bf16(PAF(3), VFR(7), o[1], 0, 0, 0), C1, 12); \
    } while (0)
  int t = 1;
  for (; t + 5 < NT; t += 2) {
    STEP(pB0, pB1, pA0, pA1, t, true, true, true);     WAIT_BAR(2); RESC(); ROT();
    STEP(pA0, pA1, pB0, pB1, t + 1, true, true, true); WAIT_BAR(2); RESC(); ROT();
  }
  #define ENDW(tt) do { if ((tt) + 3 < NT) { WAIT_BAR(2); } else if ((tt) + 2 < NT) { WAIT_BAR(1); } else { WAIT_BAR(0); } } while (0)
  for (; t + 1 < NT; t += 2) {
    STEP(pB0, pB1, pA0, pA1, t, (t + 3 < NT), (t + 1 < NT), (t + 1 < NT));         ENDW(t);     RESC(); ROT();
    STEP(pA0, pA1, pB0, pB1, t + 1, (t + 4 < NT), (t + 2 < NT), (t + 2 < NT));     ENDW(t + 1); RESC(); ROT();
  }
  STEP(pB0, pB1, pA0, pA1, NT - 1, false, false, false); RESC();
  { float sacc = pB0[0] + pB0[1]; _Pragma("unroll") for (int r = 2; r < 16; ++r) sacc += pB0[r]; _Pragma("unroll") for (int r = 0; r < 16; ++r) sacc += pB1[r]; l_reg += sacc;
    pw0 = (u32x4){PKW(pB0, 0), PKW(pB0, 2), PKW(pB0, 4), PKW(pB0, 6)}; pw1 = (u32x4){PKW(pB0, 8), PKW(pB0, 10), PKW(pB0, 12), PKW(pB0, 14)}; pw2 = (u32x4){PKW(pB1, 0), PKW(pB1, 2), PKW(pB1, 4), PKW(pB1, 6)}; pw3 = (u32x4){PKW(pB1, 8), PKW(pB1, 10), PKW(pB1, 12), PKW(pB1, 14)};
    SBAR(); pv(o, vb0 + sl_cur, PAF(0), PAF(1), PAF(2), PAF(3)); }
  #undef PKW
  #undef PAF
  #undef VFR
  #undef PIN
  #undef MX3
  #undef GAPA
  #undef GAPB
  #undef EX
  #undef VRD
  #undef KRD
  #undef STEP
  #undef ENDW
  { auto rr = __builtin_amdgcn_permlane32_swap(__float_as_uint(l_reg), __float_as_uint(l_reg), false, false); l_reg = __uint_as_float(rr[0]) + __uint_as_float(rr[1]); }
  if (hi == 0) wsf[32 + r32] = l_reg; asm volatile("s_waitcnt lgkmcnt(0)" ::: "memory");
  float rli[16];
  #pragma unroll
  for (int r = 0; r < 16; ++r) rli[r] = __builtin_amdgcn_rcpf(wsf[32 + crow(r, hi)]);
  bf16* Ow = O + (rowbase + q0 + wid * QBLK) * OP + h * 64;
  { bf16* stg = (bf16*)(shm + LDS_OST) + wid * 2048;
    #pragma unroll
    for (int r = 0; r < 16; ++r) { const int orow = crow(r, hi);
      #pragma unroll
      for (int d0 = 0; d0 < 2; ++d0) stg[orow * 64 + d0 * 32 + r32] = __float2bfloat16(o[d0][r] * rli[r]); }
    asm volatile("s_waitcnt lgkmcnt(0)" ::: "memory");
    #pragma unroll
    for (int i = 0; i < 4; ++i) { const int row = i * 8 + (lane >> 3), ch = lane & 7; const u32x4 v = *(const u32x4*)(stg + row * 64 + ch * 8); *(u32x4*)(Ow + (long)row * OP + ch * 8) = v; } }
  asm volatile("s_waitcnt lgkmcnt(0)\n\ts_barrier" ::: "memory");
  #undef DMA_K
  #undef DMA_V
  #undef START
  #undef RESC
  #undef ROT
}
#undef SBAR
#undef WAIT_BAR
}


#define XB_TMO      128
#define XB_XCNT(j)  (256  + 64 * (j))
#define XB_XSUB(j)  (1280 + 64 * (j))
#define XB_XGEN(j)  (2304 + 64 * (j))
#define XB_TOP      3328
#define XB_TOPGEN   3392
#define XCD_BAR_WORDS 3456
#define XB_SPIN_CAP (1u << 18)
__device__ __forceinline__ unsigned xb_ld(unsigned* p)              { return __hip_atomic_load(p, __ATOMIC_RELAXED, __HIP_MEMORY_SCOPE_AGENT); }
__device__ __forceinline__ unsigned xb_add(unsigned* p, unsigned v) { return __hip_atomic_fetch_add(p, v, __ATOMIC_RELAXED, __HIP_MEMORY_SCOPE_AGENT); }
__device__ __forceinline__ unsigned xb_xcc_id() { return (unsigned)__builtin_amdgcn_s_getreg((3 << 11) | 20) & 0xFu; }
#define XB_SPIN(cond, bar) do { unsigned _sp = 0; while (cond) { __builtin_amdgcn_s_sleep(1); \
    if ((++_sp & 255u) == 0u) { if (xb_ld(&(bar)[XB_TMO])) break; if (_sp > XB_SPIN_CAP) { atomicAdd(&(bar)[XB_TMO], 1u); break; } } } } while (0)
struct XcdBarrier { unsigned* bar; unsigned x; volatile LAS unsigned* st; };
__device__ __forceinline__ XcdBarrier xcd_barrier_post(unsigned* bar, volatile LAS unsigned* st) {
    XcdBarrier b; b.bar = bar; b.x = xb_xcc_id(); b.st = st;
    if (threadIdx.x == 0) (void)xb_add(&bar[XB_XCNT(b.x)], 1u);
    return b;
}
__device__ __forceinline__ void xcd_barrier_complete(unsigned* bar, unsigned x, unsigned& nloc, unsigned& nx) {
    const unsigned G = gridDim.x * gridDim.y * gridDim.z;
    unsigned sum, cnt, mine, sp = 0u;
    for (;;) {
        sum = 0u; cnt = 0u; mine = 0u;
#pragma unroll
        for (unsigned j = 0; j < 16; ++j) { const unsigned c = xb_ld(&bar[XB_XCNT(j)]); sum += c; cnt += (c > 0u) ? 1u : 0u; mine = (j == x) ? c : mine; }
        if (sum == G) break;
        __builtin_amdgcn_s_sleep(1);
        if ((++sp & 255u) == 0u) { if (xb_ld(&bar[XB_TMO])) break; if (sp > XB_SPIN_CAP) { atomicAdd(&bar[XB_TMO], 1u); break; } }
    }
    nloc = mine > 0u ? mine : 1u; nx = cnt > 0u ? cnt : 1u;
}
__device__ __forceinline__ void xcd_barrier(const XcdBarrier& b) {
    asm volatile("s_waitcnt vmcnt(0)" ::: "memory");
    __syncthreads();
    if (threadIdx.x == 0) {
        unsigned* bar = b.bar;
        __builtin_amdgcn_s_waitcnt(0);
        unsigned nloc = b.st[0], nx = b.st[1];
        if (nloc == 0u) { xcd_barrier_complete(bar, b.x, nloc, nx); b.st[0] = nloc; b.st[1] = nx; }
        const unsigned old = xb_add(&bar[XB_XSUB(b.x)], 1u);
        const unsigned gen = old / nloc;
        if (old + 1u == (gen + 1u) * nloc) {
            __builtin_amdgcn_fence(__ATOMIC_RELEASE, "agent");
            asm volatile("s_waitcnt vmcnt(0)" ::: "memory");
            const unsigned og = xb_add(&bar[XB_TOP], 1u);
            const unsigned tg = og / nx;
            if (og + 1u == (tg + 1u) * nx) xb_add(&bar[XB_TOPGEN], 1u);
            else XB_SPIN(xb_ld(&bar[XB_TOPGEN]) == tg, bar);
            __builtin_amdgcn_fence(__ATOMIC_ACQUIRE, "agent");
            xb_add(&bar[XB_XGEN(b.x)], 1u);
            asm volatile("s_waitcnt vmcnt(0)" ::: "memory");
        } else {
            XB_SPIN(xb_ld(&bar[XB_XGEN(b.x)]) == gen, bar);
            __builtin_amdgcn_fence(__ATOMIC_ACQUIRE, "agent");
            asm volatile("s_waitcnt vmcnt(0)" ::: "memory");
        }
    }
    __syncthreads();
}

constexpr int RING_BYTES = 131072, MISC_OFF = RING_BYTES + 320, LDS_BYTES = 147456;
constexpr size_t WS_BAR = 65536;
constexpr size_t WS_TW = 131072;
constexpr size_t WS_FC = 196608, WS_FS = 196608 + 8192;
static_assert(attn_body::LDS_BYTES <= RING_BYTES, "attention scratch");

struct Args { const float* in[16]; float* out; unsigned char* ws; };
enum { I_X = 0, I_GPRE, I_WIN, I_SW, I_SB, I_SG, I_GQ, I_GK, I_GMIX, I_WOUT, I_GPOSTM, I_GPREF, I_WG, I_WU, I_WD, I_GPOSTF };

__device__ __forceinline__ void transpose_item(const float* W, int ldw, int k0, int n0, bf16_t* WT, int ldt, int drow0, LAS float* scr, int lane) {
#pragma unroll 8
    for (int i = 0; i < 32; ++i) { const int kk = 2 * i + (lane >> 5); scr[kk * 33 + (lane & 31)] = W[(size_t)(k0 + kk) * ldw + n0 + (lane & 31)]; }
    asm volatile("s_waitcnt lgkmcnt(0)" ::: "memory");
    const int c = lane & 7;
#pragma unroll
    for (int j = 0; j < 4; ++j) { const int n = (lane >> 3) + 8 * j; const LAS float* s = scr + (8 * c) * 33 + n;
        u32x4 o; o.x = pk2(s[0 * 33], s[1 * 33]); o.y = pk2(s[2 * 33], s[3 * 33]); o.z = pk2(s[4 * 33], s[5 * 33]); o.w = pk2(s[6 * 33], s[7 * 33]);
        *(u32x4*)(WT + (size_t)(drow0 + n) * ldt + k0 + 8 * c) = o; }
    asm volatile("s_waitcnt lgkmcnt(0)" ::: "memory");
}

__device__ __forceinline__ void resnorm_row(const bf16_t* mrow, const float* base, float* out, const float* gpost, const float* gnext, bf16_t* xn, int lane) {
    f32x4 xv[4]; float mv[4][4]; float ss = 0.f;
#pragma unroll
    for (int j = 0; j < 4; ++j) { const u32x2 w = *(const u32x2*)(mrow + 256 * j + 4 * lane); xv[j] = *(const f32x4*)(base + 256 * j + 4 * lane);
        mv[j][0] = bflo(w.x); mv[j][1] = bfhi(w.x); mv[j][2] = bflo(w.y); mv[j][3] = bfhi(w.y);
        ss += (mv[j][0] * mv[j][0] + mv[j][1] * mv[j][1]) + (mv[j][2] * mv[j][2] + mv[j][3] * mv[j][3]); }
    const float r1 = 1.0f / sqrtf(wave_sum(ss) * (1.0f / 1024.0f) + EPS); float s2 = 0.f;
#pragma unroll
    for (int j = 0; j < 4; ++j) { const f32x4 g = *(const f32x4*)(gpost + 256 * j + 4 * lane);
#pragma unroll
        for (int e = 0; e < 4; ++e) { xv[j][e] += mv[j][e] * r1 * g[e]; s2 += xv[j][e] * xv[j][e]; }
        *(f32x4*)(out + 256 * j + 4 * lane) = xv[j]; }
    if (xn) { const float r2 = 1.0f / sqrtf(wave_sum(s2) * (1.0f / 1024.0f) + EPS);
#pragma unroll
        for (int j = 0; j < 4; ++j) { const f32x4 g = *(const f32x4*)(gnext + 256 * j + 4 * lane);
            u32x2 w; w.x = pk2(xv[j][0] * r2 * g[0], xv[j][1] * r2 * g[1]); w.y = pk2(xv[j][2] * r2 * g[2], xv[j][3] * r2 * g[3]);
            *(u32x2*)(xn + 256 * j + 4 * lane) = w; } }
}

__device__ __forceinline__ void sgu_unit(int unit, const bf16_t* Z, const float* Ws, const float* bs, const float* gv, const float* gmix, bf16_t* Y, LAS unsigned char* lds, int tid) {
    const int lane = tid & 63, w = __builtin_amdgcn_readfirstlane(tid >> 6), fr = lane & 15, fq = lane >> 4;
    const int row0 = unit * 128;
    constexpr int VTP = 272;
    LAS unsigned char* VT = lds; LAS float* SS = (LAS float*)(lds + 256 * VTP);
    {
        const int r = tid >> 2, qd = tid & 3;
        const bf16_t* vp = Z + (size_t)(row0 + r) * ZP + ZC_V + 64 * qd;
        u32x4 raw[8]; float s = 0.f;
#pragma unroll
        for (int j = 0; j < 8; ++j) { raw[j] = *(const u32x4*)(vp + 8 * j);
#pragma unroll
            for (int e = 0; e < 4; ++e) s += bflo(raw[j][e]) + bfhi(raw[j][e]); }
        s += __shfl_xor(s, 1); s += __shfl_xor(s, 2);
        const float mu = s * (1.0f / 256.0f); float q = 0.f;
#pragma unroll
        for (int j = 0; j < 8; ++j)
#pragma unroll
            for (int e = 0; e < 4; ++e) { const float a = bflo(raw[j][e]) - mu, b = bfhi(raw[j][e]) - mu; q += a * a + b * b; }
        q += __shfl_xor(q, 1); q += __shfl_xor(q, 2);
        const float rstd = 1.0f / sqrtf(q * (1.0f / 256.0f) + EPS);
#pragma unroll
        for (int j = 0; j < 8; ++j)
#pragma unroll
            for (int e = 0; e < 4; ++e) { const int c = 64 * qd + 8 * j + 2 * e;
                const float a = (bflo(raw[j][e]) - mu) * rstd * gv[c], b = (bfhi(raw[j][e]) - mu) * rstd * gv[c + 1];
                *(LAS bf16_t*)(VT + c * VTP + r * 2) = (bf16_t)f2bf(a); *(LAS bf16_t*)(VT + (c + 1) * VTP + r * 2) = (bf16_t)f2bf(b); }
    }
    __syncthreads();
    const int h = w >> 1, cbase = 64 * h + 32 * (w & 1);
    bf16x8 bfr[2][4];
#pragma unroll
    for (int n = 0; n < 2; ++n)
#pragma unroll
        for (int kk = 0; kk < 4; ++kk) bfr[n][kk] = *(const LAS bf16x8*)(VT + (cbase + 16 * n + fr) * VTP + (32 * kk + 8 * fq) * 2);
    f32x4 acc[8][2];
    const float* Wh = Ws + (size_t)h * 128 * 128;
#pragma unroll
    for (int m = 0; m < 8; ++m) {
        acc[m][0] = (f32x4){0.f, 0.f, 0.f, 0.f}; acc[m][1] = (f32x4){0.f, 0.f, 0.f, 0.f};
#pragma unroll
        for (int kk = 0; kk < 4; ++kk) {
            const float* ap = Wh + (size_t)(16 * m + fr) * 128 + 32 * kk + 8 * fq;
            const f32x4 a0 = *(const f32x4*)ap, a1 = *(const f32x4*)(ap + 4);
            u32x4 aw; aw.x = pk2(a0[0], a0[1]); aw.y = pk2(a0[2], a0[3]); aw.z = pk2(a1[0], a1[1]); aw.w = pk2(a1[2], a1[3]);
            const bf16x8 af = __builtin_bit_cast(bf16x8, aw);
            acc[m][0] = __builtin_amdgcn_mfma_f32_16x16x32_bf16(bfr[0][kk], af, acc[m][0], 0, 0, 0);
            acc[m][1] = __builtin_amdgcn_mfma_f32_16x16x32_bf16(bfr[1][kk], af, acc[m][1], 0, 0, 0);
        }
    }
#pragma unroll
    for (int m = 0; m < 8; ++m) { const int p = 16 * m + fr; const float bias = bs[h * 128 + p]; float ss = 0.f;
#pragma unroll
        for (int n = 0; n < 2; ++n) { const int c = cbase + 16 * n + 4 * fq; const u32x2 uw = *(const u32x2*)(Z + (size_t)(row0 + p) * ZP + ZC_U + c);
            f32x4 v = acc[m][n]; v[0] = (v[0] + bias) * bflo(uw.x); v[1] = (v[1] + bias) * bfhi(uw.x); v[2] = (v[2] + bias) * bflo(uw.y); v[3] = (v[3] + bias) * bfhi(uw.y);
            acc[m][n] = v; ss += (v[0] * v[0] + v[1] * v[1]) + (v[2] * v[2] + v[3] * v[3]); }
        ss += __shfl_xor(ss, 16); ss += __shfl_xor(ss, 32);
        if (fq == 0) SS[w * 128 + p] = ss; }
    __syncthreads();
#pragma unroll
    for (int m = 0; m < 8; ++m) { const int p = 16 * m + fr; float tot = 0.f;
#pragma unroll
        for (int ww = 0; ww < 8; ++ww) tot += SS[ww * 128 + p];
        const float rr = 1.0f / sqrtf(tot * (1.0f / 256.0f) + EPS);
#pragma unroll
        for (int n = 0; n < 2; ++n) { const int c = cbase + 16 * n + 4 * fq; const f32x4 g = *(const f32x4*)(gmix + 256 + c); const f32x4 v = acc[m][n];
            u32x2 ow; ow.x = pk2(v[0] * rr * g[0], v[1] * rr * g[1]); ow.y = pk2(v[2] * rr * g[2], v[3] * rr * g[3]);
            *(u32x2*)(Y + (size_t)(row0 + p) * DM + 256 + c) = ow; } }
    __syncthreads();
}

__device__ __forceinline__ void fft_col(int col, const bf16_t* ZFt, bf16_t* YFt, const f32x2* TW, const u32x4* FCI, const u32x4* FSI, LAS unsigned char* wl, int lane) {
    { int l_ = lane; asm volatile("" : "+v"(l_)); lane = l_; }
    const int b = col >> 8, c = col & 255, fr = lane & 15, fq = lane >> 4;
    const bf16_t* a1 = ZFt + (size_t)c * MTOK + (size_t)b * SEQ; const bf16_t* b1 = ZFt + (size_t)(256 + c) * MTOK + (size_t)b * SEQ;
#pragma unroll
    for (int j = 0; j < 8; ++j) { const int q = 64 * j + lane, n1 = q >> 3, n20 = (q & 7) * 8;
        const u32x4 va = *(const u32x4*)(a1 + 64 * n1 + n20), vb = *(const u32x4*)(b1 + 64 * n1 + n20);
#pragma unroll
        for (int e = 0; e < 8; ++e) { const unsigned xa = (e & 1) ? (va[e >> 1] >> 16) : (va[e >> 1] & 0xffffu), xb = ((e & 1) ? (vb[e >> 1] >> 16) : (vb[e >> 1] & 0xffffu)) ^ 0x8000u;
            const int off = (n20 + e) * 128 + (((n1 >> 3) ^ e) * 16) + (n1 & 7) * 2;
            *(LAS bf16_t*)(wl + off) = (bf16_t)xa; *(LAS bf16_t*)(wl + 8192 + off) = (bf16_t)xb; } }
    bf16x8 Cf[8], Sf[8];
#pragma unroll
    for (int f = 0; f < 8; ++f) { Cf[f] = __builtin_bit_cast(bf16x8, FCI[f * 64 + lane]); Sf[f] = __builtin_bit_cast(bf16x8, FSI[f * 64 + lane]); }
    f32x4 Tre[4][4], Tim[4][4];
#pragma unroll
    for (int m = 0; m < 4; ++m)
#pragma unroll
        for (int nb = 0; nb < 4; ++nb) { Tre[m][nb] = (f32x4){0.f, 0.f, 0.f, 0.f}; Tim[m][nb] = (f32x4){0.f, 0.f, 0.f, 0.f}; }
#pragma unroll
    for (int nb = 0; nb < 4; ++nb)
#pragma unroll
        for (int kk = 0; kk < 2; ++kk) { const int roff = (16 * nb + fr) * 128 + (((4 * kk + fq) ^ (fr & 7)) * 16);
            const u32x4 zr = *(const LAS u32x4*)(wl + roff), zi = *(const LAS u32x4*)(wl + 8192 + roff); const u32x4 nz = zr ^ 0x80008000u;
            const bf16x8 zre = __builtin_bit_cast(bf16x8, zr), zim = __builtin_bit_cast(bf16x8, zi), nzre = __builtin_bit_cast(bf16x8, nz);
#pragma unroll
            for (int m = 0; m < 4; ++m) {
                Tre[m][nb] = __builtin_amdgcn_mfma_f32_16x16x32_bf16(zre, Cf[2 * m + kk], Tre[m][nb], 0, 0, 0); Tre[m][nb] = __builtin_amdgcn_mfma_f32_16x16x32_bf16(zim, Sf[2 * m + kk], Tre[m][nb], 0, 0, 0);
                Tim[m][nb] = __builtin_amdgcn_mfma_f32_16x16x32_bf16(zim, Cf[2 * m + kk], Tim[m][nb], 0, 0, 0); Tim[m][nb] = __builtin_amdgcn_mfma_f32_16x16x32_bf16(nzre, Sf[2 * m + kk], Tim[m][nb], 0, 0, 0); } }
#pragma unroll
    for (int m = 0; m < 4; ++m)
#pragma unroll
        for (int nb = 0; nb < 4; ++nb) { const int k1 = 16 * m + fr, n2 = 16 * nb + 4 * fq; float r2[4], i2[4];
#pragma unroll
            for (int e = 0; e < 4; ++e) { const f32x2 tw = TW[k1 * (n2 + e)]; const float re = Tre[m][nb][e], im = Tim[m][nb][e]; r2[e] = re * tw.x - im * tw.y; i2[e] = re * tw.y + im * tw.x; }
            u32x2 wr, wi; wr.x = pk2(r2[0], r2[1]); wr.y = pk2(r2[2], r2[3]); wi.x = pk2(i2[0], i2[1]); wi.y = pk2(i2[2], i2[3]);
            const int off = k1 * 128 + (((2 * nb + (fq >> 1)) ^ (fr & 7)) * 16) + (fq & 1) * 8;
            *(LAS u32x2*)(wl + off) = wr; *(LAS u32x2*)(wl + 8192 + off) = wi; }
    f32x4 R[4][4];
#pragma unroll
    for (int m = 0; m < 4; ++m)
#pragma unroll
        for (int nb = 0; nb < 4; ++nb) R[m][nb] = (f32x4){0.f, 0.f, 0.f, 0.f};
#pragma unroll
    for (int nb = 0; nb < 4; ++nb)
#pragma unroll
        for (int kk = 0; kk < 2; ++kk) { const int roff = (16 * nb + fr) * 128 + (((4 * kk + fq) ^ (fr & 7)) * 16);
            const bf16x8 tre = *(const LAS bf16x8*)(wl + roff), tim = *(const LAS bf16x8*)(wl + 8192 + roff);
#pragma unroll
            for (int m = 0; m < 4; ++m) { R[m][nb] = __builtin_amdgcn_mfma_f32_16x16x32_bf16(tre, Cf[2 * m + kk], R[m][nb], 0, 0, 0); R[m][nb] = __builtin_amdgcn_mfma_f32_16x16x32_bf16(tim, Sf[2 * m + kk], R[m][nb], 0, 0, 0); } }
    bf16_t* yo = YFt + (size_t)c * MTOK + (size_t)b * SEQ;
#pragma unroll
    for (int m = 0; m < 4; ++m)
#pragma unroll
        for (int nb = 0; nb < 4; ++nb) { const f32x4 v = R[m][nb] * (1.0f / 512.0f); u32x2 w; w.x = pk2(v[0], v[1]); w.y = pk2(v[2], v[3]);
            *(u32x2*)(yo + 64 * (16 * m + fr) + 16 * nb + 4 * fq) = w; }
    asm volatile("s_waitcnt lgkmcnt(0)" ::: "memory");
}

__global__ void __launch_bounds__(NTHR, 2) hybrid_fwd(Args args) {
    extern __shared__ __attribute__((aligned(16))) unsigned char lds_raw[];
    cg::grid_group grid = cg::this_grid();
    LAS unsigned char* lds = (LAS unsigned char*)lds_raw;
    const int tid = threadIdx.x, lane = tid & 63, wave = __builtin_amdgcn_readfirstlane(tid >> 6);
    const int G = gridDim.x; const int bx = blockIdx.x; const int vcu = (G % 8 == 0) ? (bx % 8) * (G / 8) + bx / 8 : bx;
    const int gw = vcu * NWAVES + wave, NGW = G * NWAVES;
    unsigned char* ws = args.ws;
    float* ropec = (float*)(ws + WS_CTL); float* ropes = ropec + 1024;
    bf16_t* XN = (bf16_t*)(ws + WS_XN); bf16_t* MB = (bf16_t*)(ws + WS_MB);
    bf16_t* HB = (bf16_t*)(ws + WS_H); bf16_t* Zm = (bf16_t*)(ws + WS_Z); bf16_t* ZFt = (bf16_t*)(ws + WS_ZF); bf16_t* OB = (bf16_t*)(ws + WS_O); bf16_t* Y = (bf16_t*)(ws + WS_Y);
    bf16_t* YFt = (bf16_t*)(ws + WS_MB);
    f32x2* TW = (f32x2*)(ws + WS_TW); u32x4* FCI = (u32x4*)(ws + WS_FC); u32x4* FSI = (u32x4*)(ws + WS_FS);
    const float* x_in = args.in[I_X]; float* out = args.out;

    unsigned* barw = (unsigned*)(ws + WS_BAR);
    volatile LAS unsigned* MISC = (volatile LAS unsigned*)(lds + MISC_OFF);
    if (bx == 0) for (int i = tid; i < XCD_BAR_WORDS; i += NTHR) __hip_atomic_store(barw + i, 0u, __ATOMIC_RELAXED, __HIP_MEMORY_SCOPE_AGENT);
    if (tid < 2) MISC[tid] = 0u;
    {
        LAS float* scr = (LAS float*)(lds + wave * 16384);
        constexpr int IT_IN = 16 * 40, IT_OUT = 16 * 32, IT_G = 16 * 88, IT_D = 44 * 32, IT_L = IT_IN + IT_OUT + 2 * IT_G + IT_D;
        for (int it = gw; it < DEPTH * IT_L; it += NGW) {
            const int l = it / IT_L; int r = it % IT_L; unsigned char* wl = ws + WS_W + (size_t)l * WL_SIZE;
            if (r < IT_IN) { const int kb = r / 40, nb = r % 40; transpose_item(args.in[I_WIN] + (size_t)l * DM * DIN, DIN, 64 * kb, 256 + 32 * nb, (bf16_t*)(wl + WL_IN), DM, 32 * nb, scr, lane); continue; } r -= IT_IN;
            if (r < IT_OUT) { const int kb = r / 32, nb = r % 32; transpose_item(args.in[I_WOUT] + (size_t)l * DM * DM, DM, 64 * kb, 32 * nb, (bf16_t*)(wl + WL_OUT), DM, 32 * nb, scr, lane); continue; } r -= IT_OUT;
            if (r < 2 * IT_G) { const int up = r >= IT_G; if (up) r -= IT_G; const int kb = r / 88, nb = r % 88; const int n0 = 32 * nb;
                transpose_item(args.in[up ? I_WU : I_WG] + (size_t)l * DM * DFF, DFF, 64 * kb, n0, (bf16_t*)(wl + WL_GU), DM, 256 * (n0 >> 7) + (n0 & 127) + (up ? 128 : 0), scr, lane); continue; } r -= 2 * IT_G;
            { const int kb = r / 32, nb = r % 32; transpose_item(args.in[I_WD] + (size_t)l * DFF * DM, DM, 64 * kb, 32 * nb, (bf16_t*)(wl + WL_DN), DFF, 32 * nb, scr, lane); }
        }
        {
            float sn64, cs64; sincospif((float)lane * (1.0f / 32.0f), &sn64, &cs64);
            for (int it = gw; it < DEPTH * 4096; it += NGW) {
                const int l = it >> 12, k = (it & 4095) >> 2, g = it & 3;
                const float wv = args.in[I_WIN][(size_t)l * DM * DIN + (size_t)k * DIN + 64 * g + lane];
                float ac = 0.f, as = 0.f;
#pragma unroll 8
                for (int c = 0; c < 64; ++c) { const float wc = __shfl(wv, c); const int idx = (c * lane) & 63; ac += wc * __shfl(cs64, idx); as += wc * __shfl(sn64, idx); }
                bf16_t* wf = (bf16_t*)(ws + WS_W + (size_t)l * WL_SIZE + WL_F);
                wf[(size_t)(64 * g + lane) * DM + k] = (bf16_t)f2bf(ac); wf[(size_t)(256 + 64 * g + lane) * DM + k] = (bf16_t)f2bf(as);
            }
        }
        if (bx == 0) { for (int i = tid; i < 1024; i += NTHR) { const int p = i >> 4, j = i & 15; const float fr_ = powf(10000.0f, -(float)j / 16.0f); const float ang = (float)p * fr_; ropec[i] = cosf(ang); ropes[i] = sinf(ang); } }
        { int lane_ = lane; asm volatile("" : "+v"(lane_)); const int lane = lane_;
        for (int m = gw; m < MTOK; m += NGW) {
            const float* xr = x_in + (size_t)m * DM; f32x4 v[4]; float ss = 0.f;
#pragma unroll
            for (int j = 0; j < 4; ++j) { v[j] = *(const f32x4*)(xr + 256 * j + 4 * lane); ss += (v[j][0] * v[j][0] + v[j][1] * v[j][1]) + (v[j][2] * v[j][2] + v[j][3] * v[j][3]); }
            const float r = 1.0f / sqrtf(wave_sum(ss) * (1.0f / 1024.0f) + EPS);
#pragma unroll
            for (int j = 0; j < 4; ++j) { const f32x4 g = *(const f32x4*)(args.in[I_GPRE] + 256 * j + 4 * lane);
                u32x2 w; w.x = pk2(v[j][0] * r * g[0], v[j][1] * r * g[1]); w.y = pk2(v[j][2] * r * g[2], v[j][3] * r * g[3]);
                *(u32x2*)(XN + (size_t)m * DM + 256 * j + 4 * lane) = w; }
        } }
        if (bx == 0) for (int j = tid; j < 4096; j += NTHR) { float sn, cs; sincospif((float)j * (1.0f / 2048.0f), &sn, &cs); TW[j] = (f32x2){cs, -sn}; }
        if (bx == (G > 1 ? 1 : 0)) for (int i = tid; i < 4096; i += NTHR) { const int f = i >> 9, ln = (i >> 3) & 63, e = i & 7, row = 16 * (f >> 1) + (ln & 15), k = 32 * (f & 1) + 8 * (ln >> 4) + e;
            float sn, cs; sincospif((float)((row * k) & 63) * (1.0f / 32.0f), &sn, &cs);
            ((bf16_t*)FCI)[(f * 64 + ln) * 8 + e] = (bf16_t)f2bf(cs); ((bf16_t*)FSI)[(f * 64 + ln) * 8 + e] = (bf16_t)f2bf(sn); }
    }
    grid.sync();
    const XcdBarrier xbar = xcd_barrier_post(barw, MISC);
#define GSYNC() xcd_barrier(xbar)

#pragma unroll 1
    for (int l = 0; l < DEPTH; ++l) {
        unsigned char* wl = ws + WS_W + (size_t)l * WL_SIZE;
        const float* gmix = args.in[I_GMIX] + l * 1024;
        {
            pg8::Gemm g{XN, (const bf16_t*)(wl + WL_IN), DM, DM, DM}; pg8::StaticOrder S; S.init(MTOK, 1280, G, bx);
            pg8::EpiBf16<1> E{Zm, ZP};
            pg8::gemm_phase<pg8::EpiBf16<1>, pg8::StaticOrder, true>(lds, g, S, E);
        }
        {
            pg8::Gemm g{(const bf16_t*)(wl + WL_F), XN, DM, DM, DM}; pg8::StaticOrder S; S.init(512, MTOK, G, G - 1 - bx);
            pg8::EpiBf16<0> E{ZFt, MTOK};
            pg8::gemm_phase<pg8::EpiBf16<0>, pg8::StaticOrder, true>(lds, g, S, E);
        }
        GSYNC();
        {
            const float* gk = args.in[I_GK] + l * 64;
            { int lane_ = lane; asm volatile("" : "+v"(lane_)); const int lane = lane_;
            for (int m = gw; m < MTOK; m += NGW) {
                const int hh = lane >> 5, j = lane & 31, t = j >> 4, i = j & 15;
                bf16_t* kp = Zm + (size_t)m * ZP + ZC_K + hh * 64 + 32 * t + i;
                const float a = bflo((unsigned)kp[0]), b = bflo((unsigned)kp[16]);
                float ss = a * a + b * b;
#pragma unroll
                for (int o = 1; o < 32; o <<= 1) ss += __shfl_xor(ss, o);
                const float r = 1.0f / sqrtf(ss * (1.0f / 64.0f) + EPS);
                const int pos = m & (SEQ - 1), pp = t ? (pos & 63) : (pos >> 6);
                const float cs = ropec[pp * 16 + i], sn = ropes[pp * 16 + i];
                const float x1 = a * r * gk[32 * t + i], x2 = b * r * gk[32 * t + 16 + i];
                kp[0] = (bf16_t)f2bf(x1 * cs - x2 * sn); kp[16] = (bf16_t)f2bf(x2 * cs + x1 * sn);
            } }
            int tid_ = tid; asm volatile("" : "+v"(tid_));
            for (int u = vcu; u < MTOK / 128; u += G)
                sgu_unit(u, Zm, args.in[I_SW] + (size_t)l * 4 * 128 * 128, args.in[I_SB] + l * 512, args.in[I_SG] + l * 256, gmix, Y, lds, tid_);
            { int lane_ = lane; asm volatile("" : "+v"(lane_));
              for (int col = gw; col < NB * 256; col += NGW) fft_col(col, ZFt, YFt, TW, FCI, FSI, lds + wave * 16384, lane_); }
        }
        GSYNC();
        {
            const float* gq = args.in[I_GQ] + l * 64;
            for (int idx = vcu; idx < 1024; idx += G) {
                const int x = (idx & 255) >> 5, j = idx & 31, i = idx >> 8, lu = i * 32 + j, pair = 2 * x + (lu >> 6), wi = lu & 63;
                const int b = pair >> 1, kvh = pair & 1, h = kvh * 4 + (wi >> 4), qb = wi & 15;
                attn_body::attn_unit<8>(b, h, qb, (const attn_body::bf16*)Zm, (attn_body::bf16*)OB, gq, ropec, ropes, (char*)lds_raw);
            }
        }
        GSYNC();
        { int tid_ = tid; asm volatile("" : "+v"(tid_)); const int lane = tid_ & 63;
          constexpr int TP = 516;
          for (int tile = vcu; tile < MTOK / 128; tile += G) { const int t0 = tile * 128;
#pragma unroll
            for (int j = 0; j < 8; ++j) { const int idx = j * NTHR + tid_, c = idx >> 4, tk8 = idx & 15;
                const u32x4 v = *(const u32x4*)(YFt + (size_t)c * MTOK + t0 + 8 * tk8);
#pragma unroll
                for (int e = 0; e < 8; ++e) *(LAS bf16_t*)(lds + (8 * tk8 + e) * TP + 2 * c) = (bf16_t)((e & 1) ? (v[e >> 1] >> 16) : (v[e >> 1] & 0xffffu)); }
            __syncthreads();
            const f32x2 g0 = *(const f32x2*)(gmix + 2 * lane), g1 = *(const f32x2*)(gmix + 128 + 2 * lane);
#pragma unroll 4
            for (int i = 0; i < 16; ++i) { const int tk = 16 * wave + i; const unsigned w0 = *(const LAS unsigned*)(lds + tk * TP + 4 * lane), w1 = *(const LAS unsigned*)(lds + tk * TP + 256 + 4 * lane);
                const float a = bflo(w0), b = bfhi(w0), c = bflo(w1), d = bfhi(w1);
                const float r = 1.0f / sqrtf(wave_sum((a * a + b * b) + (c * c + d * d)) * (1.0f / 256.0f) + EPS);
                bf16_t* yr = Y + (size_t)(t0 + tk) * DM;
                *(unsigned*)(yr + 2 * lane) = pk2(a * r * g0.x, b * r * g0.y); *(unsigned*)(yr + 128 + 2 * lane) = pk2(c * r * g1.x, d * r * g1.y); }
            __syncthreads(); }
          for (int m = gw; m < MTOK; m += NGW) {
            const u32x4 ow = *(const u32x4*)(OB + (size_t)m * OP + 8 * lane); float v[8];
#pragma unroll
            for (int e = 0; e < 4; ++e) { v[2 * e] = bflo(ow[e]); v[2 * e + 1] = bfhi(ow[e]); }
            float ss = 0.f;
#pragma unroll
            for (int e = 0; e < 8; ++e) ss += v[e] * v[e];
            const float r = 1.0f / sqrtf(wave_sum(ss) * (1.0f / 512.0f) + EPS);
            const f32x4 g0 = *(const f32x4*)(gmix + 512 + 8 * lane), g1 = *(const f32x4*)(gmix + 512 + 8 * lane + 4);
            u32x4 w; w.x = pk2(v[0] * r * g0[0], v[1] * r * g0[1]); w.y = pk2(v[2] * r * g0[2], v[3] * r * g0[3]); w.z = pk2(v[4] * r * g1[0], v[5] * r * g1[1]); w.w = pk2(v[6] * r * g1[2], v[7] * r * g1[3]);
            *(u32x4*)(Y + (size_t)m * DM + 512 + 8 * lane) = w; }
        }
        GSYNC();
        {
            pg8::Gemm g{Y, (const bf16_t*)(wl + WL_OUT), DM, DM, DM}; pg8::StaticOrder S; S.init(MTOK, DM, G, bx);
            pg8::EpiBf16<0> E{MB, DM};
            pg8::gemm_phase<pg8::EpiBf16<0>, pg8::StaticOrder, true>(lds, g, S, E);
        }
        GSYNC();
        { int lane_ = lane; asm volatile("" : "+v"(lane_));
        for (int m = gw; m < MTOK; m += NGW)
            resnorm_row(MB + (size_t)m * DM, (l == 0 ? x_in : out) + (size_t)m * DM, out + (size_t)m * DM, args.in[I_GPOSTM] + l * DM, args.in[I_GPREF] + l * DM, XN + (size_t)m * DM, lane_); }
        GSYNC();
        {
            pg8::Gemm g{XN, (const bf16_t*)(wl + WL_GU), DM, DM, DM}; pg8::StaticOrder S; S.init(MTOK, 2 * DFF, G, bx);
            pg8::EpiSwiglu E{HB, DFF};
            pg8::gemm_phase<pg8::EpiSwiglu, pg8::StaticOrder, true>(lds, g, S, E);
        }
        GSYNC();
        {
            pg8::Gemm g{HB, (const bf16_t*)(wl + WL_DN), DFF, DFF, DFF}; pg8::StaticOrder S; S.init(MTOK, DM, G, bx);
            pg8::EpiBf16<0> E{MB, DM};
            pg8::gemm_phase<pg8::EpiBf16<0>, pg8::StaticOrder, true>(lds, g, S, E);
        }
        GSYNC();
        {
            const bool more = (l + 1 < DEPTH);
            int lane_ = lane; asm volatile("" : "+v"(lane_));
            for (int m = gw; m < MTOK; m += NGW)
                resnorm_row(MB + (size_t)m * DM, out + (size_t)m * DM, out + (size_t)m * DM, args.in[I_GPOSTF] + l * DM, more ? args.in[I_GPRE] + (l + 1) * DM : nullptr, more ? XN + (size_t)m * DM : nullptr, lane_);
            if (more) GSYNC();
        }
    }
}

extern "C" void kernel_launch(void* const* d_in, const int* in_sizes, int n_in, void* d_out, int out_size, void* d_ws, size_t ws_size, hipStream_t stream) {
    static int grid = 0;
    if (grid == 0) {
        if (n_in != 16 || in_sizes[0] != MTOK * DM || out_size != MTOK * DM || ws_size < WS_END) { fprintf(stderr, "kernel_launch: unexpected shapes (n_in %d, in0 %d, out %d, ws %zu)\n", n_in, n_in > 0 ? in_sizes[0] : -1, out_size, ws_size); grid = -1; return; }
        int dev = 0, cus = 0, per_cu = 0;
        hipGetDevice(&dev); hipDeviceGetAttribute(&cus, hipDeviceAttributeMultiprocessorCount, dev);
        hipFuncSetAttribute((const void*)hybrid_fwd, hipFuncAttributeMaxDynamicSharedMemorySize, LDS_BYTES);
        hipOccupancyMaxActiveBlocksPerMultiprocessor(&per_cu, (const void*)hybrid_fwd, NTHR, LDS_BYTES);
        if (per_cu < 1) { fprintf(stderr, "kernel_launch: occupancy query reports %d blocks per CU\n", per_cu); per_cu = 1; }
        (void)hipGetLastError();
        grid = cus * (per_cu > 1 ? 1 : per_cu);
    }
    if (grid < 0) return;
    Args a{};
    for (int i = 0; i < 16; ++i) a.in[i] = (const float*)d_in[i];
    a.out = (float*)d_out; a.ws = (unsigned char*)d_ws;
    void* kargs[] = {&a};
    hipError_t e = hipLaunchCooperativeKernel((const void*)hybrid_fwd, dim3(grid), dim3(NTHR), kargs, LDS_BYTES, stream);
    if (e != hipSuccess) fprintf(stderr, "cooperative launch failed: %s (grid %d)\n", hipGetErrorString(e), grid);
}
```
